# Optimizing an MI355X kernel written in HIP

```python
import jax
import jax.numpy as jnp
from jax import lax
import numpy as np

D_MODEL = 1024
BATCH = 32
SEQ = 2048
DEPTH = 4

CTX_LEN = 256
GRID_W = 64
EPS = 1e-6
ROPE_THETA = 10000.0
Q_BLOCK = 128
N_ATTN_LAYERS = (DEPTH + 1) // 2
N_FC_LAYERS = DEPTH // 2

MLA_HEADS = 4
MLA_Q_RANK = D_MODEL // 2
MLA_KV_RANK = D_MODEL // 4
MLA_NOPE = 128
MLA_ROPE = 64
MLA_V = 128
MLA_SCALE = (MLA_NOPE + MLA_ROPE) ** -0.5

GQA_HEADS = 4
GQA_KV_HEADS = 2
GQA_GROUP = GQA_HEADS // GQA_KV_HEADS
GQA_HEAD_DIM = 128
GQA_SCALE = GQA_HEAD_DIM ** -0.5

FNET_GROUPS = 4
FNET_GROUP_W = 128
FNET_W = FNET_GROUPS * FNET_GROUP_W
CONV_CH = 512
CONV_K = 31

D_FF = 4 * D_MODEL
N_MOD = 6

ATTN_Q_W = MLA_Q_RANK + GQA_HEADS * GQA_HEAD_DIM
ATTN_KV_W = MLA_KV_RANK + MLA_ROPE + 2 * GQA_KV_HEADS * GQA_HEAD_DIM
ATTN_IN_W = ATTN_Q_W + ATTN_KV_W
ATTN_MIX_W = MLA_HEADS * MLA_V + GQA_HEADS * GQA_HEAD_DIM
FC_IN_W = FNET_W + 2 * CONV_CH
FC_MIX_W = FNET_W + CONV_CH

kernel_name = 'hybrid_mla_gqa_fnet_conformer_dit_block'


def rms_norm(x, g):
    xf = x.astype(jnp.float32)
    y = xf * lax.rsqrt(jnp.mean(xf * xf, axis=-1, keepdims=True) + EPS)
    return (y * g.astype(jnp.float32)).astype(x.dtype)


def layer_norm(x, g, b):
    xf = x.astype(jnp.float32)
    mu = jnp.mean(xf, axis=-1, keepdims=True)
    var = jnp.mean(jnp.square(xf - mu), axis=-1, keepdims=True)
    y = (xf - mu) * lax.rsqrt(var + EPS)
    return (y * g.astype(jnp.float32) + b.astype(jnp.float32)).astype(x.dtype)


def adaln_params(cond, w, b):
    m = jax.nn.silu(cond) @ w + b
    return jnp.split(m[:, None, :], N_MOD, axis=-1)


def modulate(h, shift, scale):
    return h * (1 + scale) + shift


def rope_1d(x, pos):
    half = x.shape[-1] // 2
    freqs = ROPE_THETA ** (-jnp.arange(half, dtype=jnp.float32) / half)
    ang = pos.astype(jnp.float32)[:, None] * freqs[None, :]
    cos = jnp.cos(ang)[None, :, None, :]
    sin = jnp.sin(ang)[None, :, None, :]
    xf = x.astype(jnp.float32)
    x1, x2 = xf[..., :half], xf[..., half:]
    return jnp.concatenate([x1 * cos - x2 * sin, x1 * sin + x2 * cos], axis=-1).astype(x.dtype)


def rope_2d(x, pos):
    if pos is None:
        return x
    row, col = pos
    half = x.shape[-1] // 2
    return jnp.concatenate([rope_1d(x[..., :half], row), rope_1d(x[..., half:], col)], axis=-1)


def attention(q, k, v, scale):
    b, s, hkv, g, dk = q.shape
    nb = s // Q_BLOCK
    qb = jnp.moveaxis(q.reshape(b, nb, Q_BLOCK, hkv, g, dk), 1, 0)

    def block(qblk):
        sc = jnp.einsum('bqhgd,bthd->bhgqt', qblk, k).astype(jnp.float32) * scale
        p = jax.nn.softmax(sc, axis=-1).astype(v.dtype)
        return jnp.einsum('bhgqt,bthe->bqhge', p, v)

    o = lax.map(block, qb)
    return jnp.moveaxis(o, 0, 1).reshape(b, s, hkv * g * v.shape[-1])


def attn_queries(pq, q_norm_g, w_uq, qk_norm_g, pos):
    b, t, _ = pq.shape
    cq = rms_norm(pq[..., :MLA_Q_RANK], q_norm_g)
    q = (cq @ w_uq).reshape(b, t, MLA_HEADS, MLA_NOPE + MLA_ROPE)
    q_mla = jnp.concatenate([q[..., :MLA_NOPE], rope_2d(q[..., MLA_NOPE:], pos)], axis=-1)
    q_gqa = rope_2d(rms_norm(pq[..., MLA_Q_RANK:].reshape(b, t, GQA_HEADS, GQA_HEAD_DIM), qk_norm_g), pos)
    return (q_mla.reshape(b, t, MLA_HEADS, 1, MLA_NOPE + MLA_ROPE),
            q_gqa.reshape(b, t, GQA_KV_HEADS, GQA_GROUP, GQA_HEAD_DIM))


def attn_keys_values(pkv, kv_norm_g, w_ukv, k_norm_g, pos):
    b, t, _ = pkv.shape
    o1 = MLA_KV_RANK
    o2 = o1 + MLA_ROPE
    o3 = o2 + GQA_KV_HEADS * GQA_HEAD_DIM
    ckv = rms_norm(pkv[..., :o1], kv_norm_g)
    kv = (ckv @ w_ukv).reshape(b, t, MLA_HEADS, MLA_NOPE + MLA_V)
    k_rope = rope_2d(pkv[..., o1:o2].reshape(b, t, 1, MLA_ROPE), pos)
    k_mla = jnp.concatenate([kv[..., :MLA_NOPE], jnp.broadcast_to(k_rope, (b, t, MLA_HEADS, MLA_ROPE))], axis=-1)
    v_mla = kv[..., MLA_NOPE:]
    k_gqa = rope_2d(rms_norm(pkv[..., o2:o3].reshape(b, t, GQA_KV_HEADS, GQA_HEAD_DIM), k_norm_g), pos)
    v_gqa = pkv[..., o3:].reshape(b, t, GQA_KV_HEADS, GQA_HEAD_DIM)
    return (k_mla, v_mla, k_gqa, v_gqa)


def attn_mix(q, kv, w_out):
    q_mla, q_gqa = q
    k_mla, v_mla, k_gqa, v_gqa = kv
    o_mla = attention(q_mla, k_mla, v_mla, MLA_SCALE)
    o_gqa = attention(q_gqa, k_gqa, v_gqa, GQA_SCALE)
    return jnp.concatenate([o_mla, o_gqa], axis=-1) @ w_out


def fourier_conv_mix(h, w_in, conv_w, conv_b, ln_g, ln_b, w_out):
    b, t, _ = h.shape
    p = h @ w_in
    f = p[..., :FNET_W].reshape(b, t, FNET_GROUPS, FNET_GROUP_W).astype(jnp.float32)
    f = jnp.fft.fft2(f, axes=(1, 3), norm='ortho').real.astype(h.dtype).reshape(b, t, FNET_W)
    a, gate = jnp.split(p[..., FNET_W:], 2, axis=-1)
    u = a * jax.nn.sigmoid(gate)
    u = lax.conv_general_dilated(u, conv_w[:, None, :].astype(u.dtype), (1,), [(CONV_K // 2, CONV_K // 2)],
                                 dimension_numbers=('NWC', 'WIO', 'NWC'), feature_group_count=CONV_CH) + conv_b
    u = jax.nn.silu(layer_norm(u, ln_g, ln_b))
    return jnp.concatenate([f, u], axis=-1) @ w_out


def sq_relu_mlp(h, w1, w2):
    return jnp.square(jax.nn.relu(h @ w1)) @ w2


def setup_inputs(seed: int = 0) -> dict:
    key = jax.random.key(seed)
    ks = jax.random.split(key, 25)
    f32 = jnp.float32
    d = D_MODEL
    na, nf = N_ATTN_LAYERS, N_FC_LAYERS

    def nrm(k, shape, scale):
        return jax.random.normal(k, shape, f32) * scale

    def gain(k, shape):
        return 1.0 + 0.05 * jax.random.normal(k, shape, f32)

    return {
        'x': nrm(ks[0], (BATCH, SEQ, d), 1.0),
        'c': nrm(ks[1], (BATCH, d), 1.0),
        'ctx': nrm(ks[2], (BATCH, CTX_LEN, d), 1.0),
        'c_ctx': nrm(ks[3], (d,), 1.0),
        'mod_w': nrm(ks[4], (DEPTH, d, N_MOD * d), 0.5 * d ** -0.5),
        'mod_b': nrm(ks[5], (DEPTH, N_MOD * d), 0.02),
        'norm1_g': gain(ks[6], (DEPTH, d)),
        'norm2_g': gain(ks[7], (DEPTH, d)),
        'attn_w_in': nrm(ks[8], (na, d, ATTN_IN_W), d ** -0.5),
        'mla_q_norm_g': gain(ks[9], (na, MLA_Q_RANK)),
        'mla_w_uq': nrm(ks[10], (na, MLA_Q_RANK, MLA_HEADS * (MLA_NOPE + MLA_ROPE)), MLA_Q_RANK ** -0.5),
        'mla_kv_norm_g': gain(ks[11], (na, MLA_KV_RANK)),
        'mla_w_ukv': nrm(ks[12], (na, MLA_KV_RANK, MLA_HEADS * (MLA_NOPE + MLA_V)), MLA_KV_RANK ** -0.5),
        'gqa_q_norm_g': gain(ks[13], (na, GQA_HEAD_DIM)),
        'gqa_k_norm_g': gain(ks[14], (na, GQA_HEAD_DIM)),
        'attn_w_out': nrm(ks[15], (na, ATTN_MIX_W, d), ATTN_MIX_W ** -0.5),
        'fc_w_in': nrm(ks[16], (nf, d, FC_IN_W), d ** -0.5),
        'conv_w': nrm(ks[17], (nf, CONV_K, CONV_CH), CONV_K ** -0.5),
        'conv_b': nrm(ks[18], (nf, CONV_CH), 0.02),
        'conv_ln_g': gain(ks[19], (nf, CONV_CH)),
        'conv_ln_b': nrm(ks[20], (nf, CONV_CH), 0.02),
        'fc_w_out': nrm(ks[21], (nf, FC_MIX_W, d), FC_MIX_W ** -0.5),
        'mlp_w1': nrm(ks[22], (DEPTH, d, D_FF), d ** -0.5),
        'mlp_w2': nrm(ks[23], (DEPTH, D_FF, d), D_FF ** -0.5),
        'final_g': gain(ks[24], (d,)),
    }


def reference(x, c, ctx, c_ctx, mod_w, mod_b, norm1_g, norm2_g, attn_w_in, mla_q_norm_g, mla_w_uq,
              mla_kv_norm_g, mla_w_ukv, gqa_q_norm_g, gqa_k_norm_g, attn_w_out, fc_w_in, conv_w, conv_b,
              conv_ln_g, conv_ln_b, fc_w_out, mlp_w1, mlp_w2, final_g):
    s = x.shape[1]
    rows = s // GRID_W
    row = jnp.repeat(jnp.arange(rows, dtype=jnp.int32), GRID_W)
    col = jnp.tile(jnp.arange(GRID_W, dtype=jnp.int32), rows)
    pos = (row, col)
    last_attn = ((DEPTH - 1) // 2) * 2

    for i in range(DEPTH):
        ctx_mode = 'full' if i < last_attn else ('kv' if i == last_attn else 'none')
        j = i // 2
        sh1, sc1, g1, sh2, sc2, g2 = adaln_params(c, mod_w[i], mod_b[i])
        h = modulate(rms_norm(x, norm1_g[i]), sh1, sc1)
        if ctx_mode != 'none':
            csh1, csc1, cg1, csh2, csc2, cg2 = adaln_params(c_ctx[None, :], mod_w[i], mod_b[i])
            hc = modulate(rms_norm(ctx, norm1_g[i]), csh1, csc1)

        if i % 2 == 0:
            q_p = (mla_q_norm_g[j], mla_w_uq[j], gqa_q_norm_g[j])
            kv_p = (mla_kv_norm_g[j], mla_w_ukv[j], gqa_k_norm_g[j])
            w_in = attn_w_in[j]
            if ctx_mode == 'full':
                pc = hc @ w_in
                pqc, pkvc = pc[..., :ATTN_Q_W], pc[..., ATTN_Q_W:]
            else:
                pkvc = hc @ w_in[:, ATTN_Q_W:]
            kvc = attn_keys_values(pkvc, *kv_p, None)
            px = h @ w_in
            qx = attn_queries(px[..., :ATTN_Q_W], *q_p, pos)
            kvx = attn_keys_values(px[..., ATTN_Q_W:], *kv_p, pos)
            kv_all = tuple(jnp.concatenate([a, bb], axis=1) for a, bb in zip(kvc, kvx))
            x = x + g1 * attn_mix(qx, kv_all, attn_w_out[j])
            if ctx_mode == 'full':
                qc = attn_queries(pqc, *q_p, None)
                ctx = ctx + cg1 * attn_mix(qc, kvc, attn_w_out[j])
        else:
            fc_p = (fc_w_in[j], conv_w[j], conv_b[j], conv_ln_g[j], conv_ln_b[j], fc_w_out[j])
            x = x + g1 * fourier_conv_mix(h, *fc_p)
            if ctx_mode == 'full':
                ctx = ctx + cg1 * fourier_conv_mix(hc, *fc_p)

        x = x + g2 * sq_relu_mlp(modulate(rms_norm(x, norm2_g[i]), sh2, sc2), mlp_w1[i], mlp_w2[i])
        if ctx_mode == 'full':
            ctx = ctx + cg2 * sq_relu_mlp(modulate(rms_norm(ctx, norm2_g[i]), csh2, csc2), mlp_w1[i], mlp_w2[i])

    return rms_norm(x, final_g)
```

```cpp
#include <hip/hip_runtime.h>
#include <hip/hip_cooperative_groups.h>
#include <cstdio>
#include <cstdint>
namespace cg = cooperative_groups;

#define LAS __attribute__((address_space(3)))
typedef unsigned short bf16_t;
typedef short bf16x8 __attribute__((ext_vector_type(8)));
typedef short s16x4 __attribute__((ext_vector_type(4)));
typedef float f32x4 __attribute__((ext_vector_type(4)));
typedef float f32x16 __attribute__((ext_vector_type(16)));
typedef unsigned u32x4 __attribute__((ext_vector_type(4)));

constexpr int DM = 1024, NB = 32, SEQ = 2048, CTXL = 256, DFF = 4096;
constexpr int ML = NB * SEQ;
constexpr int MC = NB * CTXL;
constexpr int MT = ML + MC;
constexpr int KVL = SEQ + CTXL;
constexpr float EPS = 1e-6f;
constexpr int NMODROW = 33;
constexpr size_t MiB = 1u << 20;
constexpr size_t WS_MOD = 0;
constexpr size_t WS_CTL = 3 * MiB + 512 * 1024;
constexpr size_t WS_SC = 4 * MiB;
constexpr size_t WS_WCS = 5 * MiB;
constexpr size_t WS_A2C = 5 * MiB + 256 * 1024;
constexpr size_t WS_A2 = 8 * MiB;
constexpr size_t WS_WIN = 24 * MiB;
constexpr size_t WS_UQ = 32 * MiB;
constexpr size_t WS_UKV = 34 * MiB;
constexpr size_t WS_AOUT = 36 * MiB;
constexpr size_t WS_FCIN = 40 * MiB;
constexpr size_t WS_FCOUT = 46 * MiB;
constexpr size_t WS_W1 = 50 * MiB;
constexpr size_t WS_W2 = 82 * MiB;
constexpr size_t WS_CX = 120 * MiB;
constexpr size_t WS_H = 152 * MiB;
constexpr size_t WS_R = 296 * MiB;
constexpr size_t R_P = WS_R;
constexpr size_t R_PFM = WS_R + 144 * MiB;
constexpr size_t R_U = WS_R + 72 * MiB;
constexpr size_t R_QG = WS_R + 288 * MiB;
constexpr size_t R_KG = WS_R + 360 * MiB;
constexpr size_t R_VG = WS_R + 396 * MiB;
constexpr size_t R_CQ = WS_R + 432 * MiB;
constexpr size_t R_CKV = WS_R + 504 * MiB;
constexpr size_t R_KR = WS_R + 540 * MiB;
constexpr size_t R_QM = WS_R;
constexpr size_t R_QR = WS_R + 72 * MiB;
constexpr size_t R_KM = WS_R + 108 * MiB;
constexpr size_t R_VM = WS_R + 180 * MiB;
constexpr size_t R_YT = WS_R + 216 * MiB;
constexpr size_t R_YTC = WS_R + 344 * MiB;
constexpr size_t R_YTF = WS_R + 360 * MiB;
constexpr size_t R_YTFC = WS_R + 424 * MiB;
constexpr size_t R_HID = WS_R;
constexpr size_t R_MODWT = WS_R;
constexpr size_t WS_X = WS_R + 576 * MiB;
constexpr size_t WS_SSQ = 1016 * MiB;
constexpr size_t WS_SHIFT = 1020 * MiB + 512 * 1024;
constexpr size_t WS_SW = 114 * MiB;
constexpr size_t WS_SSQC = 118 * MiB + 512 * 1024;
constexpr size_t WS_SSQK = 119 * MiB + 256 * 1024;
constexpr size_t WS_END = 1022 * MiB;

constexpr int NTHREADS = 512, NWAVES = 8;
constexpr int RING_BYTES = 131072;
constexpr int LDS_BYTES = 163840;

__device__ __forceinline__ unsigned cvt_pk(float lo, float hi) { unsigned r; asm volatile("v_cvt_pk_bf16_f32 %0, %1, %2" : "=v"(r) : "v"(lo), "v"(hi)); return r; }
__device__ __forceinline__ float bf_lo(unsigned w) { return __uint_as_float(w << 16); }
__device__ __forceinline__ float bf_hi(unsigned w) { return __uint_as_float(w & 0xffff0000u); }
__device__ __forceinline__ void unpack8(u32x4 w, float (&v)[8]) {
    v[0] = bf_lo(w.x); v[1] = bf_hi(w.x); v[2] = bf_lo(w.y); v[3] = bf_hi(w.y); v[4] = bf_lo(w.z); v[5] = bf_hi(w.z); v[6] = bf_lo(w.w); v[7] = bf_hi(w.w); }
__device__ __forceinline__ u32x4 pack8(const float (&v)[8]) { u32x4 w; w.x = cvt_pk(v[0], v[1]); w.y = cvt_pk(v[2], v[3]); w.z = cvt_pk(v[4], v[5]); w.w = cvt_pk(v[6], v[7]); return w; }
template <int K> __device__ __forceinline__ float sx(float v) {
    static_assert(K >= 1 && K < 32, "sx: mask < 32");
    return __int_as_float(__builtin_amdgcn_ds_swizzle(__float_as_int(v), (K << 10) | 0x1F));
}
__device__ __forceinline__ float sum32x(float v) {
    auto rr = __builtin_amdgcn_permlane32_swap(__float_as_uint(v), __float_as_uint(v), false, false);
    return __uint_as_float(rr[0]) + __uint_as_float(rr[1]);
}
__device__ __forceinline__ float get32x(float v, bool lane_lt32) {
    auto rr = __builtin_amdgcn_permlane32_swap(__float_as_uint(v), __float_as_uint(v), false, false);
    return lane_lt32 ? __uint_as_float(rr[1]) : __uint_as_float(rr[0]);
}
__device__ __forceinline__ float wave_sum(float v) {
    v += sx<1>(v); v += sx<2>(v); v += sx<4>(v); v += sx<8>(v); v += sx<16>(v);
    return sum32x(v);
}
__device__ __forceinline__ int kvrow_of(int row) { return row < ML ? (row >> 11) * KVL + CTXL + (row & 2047) : ((row - ML) >> 8) * KVL + ((row - ML) & 255); }
#define LDS_WAIT() asm volatile("s_waitcnt lgkmcnt(0)" ::: "memory")
__device__ __forceinline__ int otid(int wv) { int l; asm volatile("v_mbcnt_lo_u32_b32 %0, -1, 0\n\tv_mbcnt_hi_u32_b32 %0, -1, %0" : "=v"(l)); return (wv << 6) | l; }

template <int XM> __device__ __forceinline__ void rope8(float (&v)[8], int sec, bool first, int i0, float inv_nf, int prow, int pcol, bool doit) {
    const float pos = (float)(sec ? pcol : prow);
#pragma unroll
    for (int e = 0; e < 8; ++e) {
        float pv; if constexpr (XM == 32) pv = get32x(v[e], first); else pv = sx<XM>(v[e]);
        const float fr = __builtin_amdgcn_exp2f(-(float)(i0 + e) * inv_nf * 13.287712379549449f);
        const float ang = pos * fr; const float c = __cosf(ang), s = __sinf(ang);
        const float r = first ? v[e] * c - pv * s : pv * s + v[e] * c;
        v[e] = doit ? r : v[e];
    }
}

__device__ __forceinline__ void rope_cs(float (&cs)[8], float (&sn)[8], int sec, int i0, float inv_nf, int prow, int pcol) {
    const float pos = (float)(sec ? pcol : prow);
#pragma unroll
    for (int e = 0; e < 8; ++e) { const float ang = pos * __builtin_amdgcn_exp2f(-(float)(i0 + e) * inv_nf * 13.287712379549449f); cs[e] = __cosf(ang); sn[e] = __sinf(ang); }
}
__device__ __forceinline__ void rope_apply32(float (&v)[8], const float (&cs)[8], const float (&sn)[8], bool first, bool doit) {
#pragma unroll
    for (int e = 0; e < 8; ++e) { const float pv = get32x(v[e], first); const float r = first ? v[e] * cs[e] - pv * sn[e] : pv * sn[e] + v[e] * cs[e]; v[e] = doit ? r : v[e]; }
}
namespace pg8 {
constexpr int BM = 256, BK = 64, HALF = 128, HTB = HALF * BK * 2, NXCD = 8, WGM = 8;
__device__ __forceinline__ int lds_byte(int r, int c) { const int st = (r >> 4) * 2 + (c >> 5), rr = r & 15, cc = c & 31, ob = rr * 64 + cc * 2; return st * 1024 + (ob ^ (((ob >> 9) & 1) << 5)); }
__device__ __forceinline__ void stage_rc(int b, int& R, int& C) { const int st = b / 1024, sb = b % 1024, swz = sb ^ (((sb >> 9) & 1) << 5); R = (st >> 1) * 16 + swz / 64; C = (st & 1) * 32 + (swz % 64) / 2; }
__device__ __forceinline__ int perm32(int rho) { const int n = rho >> 4, i = rho & 15; return 8 * (i >> 2) + 4 * n + (i & 3); }

struct Unit { const char* A; const char* B; int pm, pn, z, pmz, par; };

struct Sched {
    const char* A; const char* B;
    int nMz, nN, nVP, nwg, G, c, zdiv, nmine, rev;
    size_t a_tile, b_tile, a_z, b_z1, b_z2;
    __device__ __forceinline__ bool next(int i, Unit& u) const {
        if (i >= nmine) return false;
        const long L = (long)(rev ? nmine - 1 - i : i) * G + c;
        int wgid = (int)L; { const int q = nwg / NXCD, r = nwg % NXCD, xcd = wgid % NXCD, off = wgid / NXCD; wgid = (xcd < r ? xcd * (q + 1) : r * (q + 1) + (xcd - r) * q) + off; }
        const int nig = WGM * nN, gid = wgid / nig, fm = gid * WGM, gsz = (nVP - fm) < WGM ? (nVP - fm) : WGM;
        const int vp = fm + ((wgid % nig) % gsz), pn = (wgid % nig) / gsz;
        const int z = vp / nMz, pmz = vp - z * nMz;
        u.pm = vp; u.pn = pn; u.z = z; u.pmz = pmz;
        u.A = A + (size_t)z * a_z + (size_t)pmz * a_tile;
        u.B = B + (size_t)(z / zdiv) * b_z1 + (size_t)(z % zdiv) * b_z2 + (size_t)pn * b_tile;
        return true;
    }
};

enum { M_STORE = 0, M_RELU2 = 1, M_RESID = 2, M_MOD = 3, M_UQ = 4, M_UKV = 5, M_SW = 6, M_QKV = 7, M_FCIN = 8, M_D1F = 9 };
struct Epi {
    int mode;
    bf16_t* C; bf16_t* C2;
    int ldc, rmask, rshift, rstep; size_t c_z;
    bf16_t* X; const float* gate;
    const float* bias; float* modout; bf16_t* shiftout;
    const float* ssq; const float* sw;
    bf16_t* xg; const float* ng; const float* nsc; float* ssq_out; LAS unsigned char* elds;
    unsigned char* wsb; const float* gqn; const float* gkn; float* ssqc; float* ssqk;
    __device__ __forceinline__ void operator()(const f32x4 (&acc)[2][2][4][2], const Unit& u, int wr, int wc, int fr, int fq) const {
        const int colt = 32 * wc + 8 * fq;
        if (mode == M_RESID) {
            const int trow0 = u.pm * BM; const int brow = trow0 < ML ? (trow0 >> 11) : 32;
            bf16_t* xb = X + (size_t)trow0 * DM + u.pn * BM + colt;
            f32x4 gt[2][2], gn[2][2];
#pragma unroll
            for (int bj = 0; bj < 2; ++bj) {
                const int col = u.pn * BM + bj * HALF + colt;
                const float* gp = gate + (size_t)brow * 6144 + col;
                gt[bj][0] = *(const f32x4*)gp; gt[bj][1] = *(const f32x4*)(gp + 4);
                if (xg) { const float* sp = nsc + (size_t)brow * 6144 + col;
                    gn[bj][0] = *(const f32x4*)(ng + col) * (*(const f32x4*)sp + 1.f); gn[bj][1] = *(const f32x4*)(ng + col + 4) * (*(const f32x4*)(sp + 4) + 1.f); }
                else { gn[bj][0] = (f32x4){0.f, 0.f, 0.f, 0.f}; gn[bj][1] = gn[bj][0]; }
            }
            u32x4 xv[3][2];
#define RS_ROWOFF(i) ((size_t)(((i) >> 2) * HALF + wr * 64 + ((i) & 3) * 16 + fr) * DM)
#define RS_LOAD(i, slot) do { const bf16_t* p_ = xb + RS_ROWOFF(i); xv[slot][0] = *(const u32x4*)p_; xv[slot][1] = *(const u32x4*)(p_ + HALF); } while (0)
            RS_LOAD(0, 0); RS_LOAD(1, 1);
#pragma unroll
            for (int i = 0; i < 8; ++i) {
                const int slot = i % 3, ai = i >> 2, m = i & 3;
                if (i + 2 < 8) RS_LOAD(i + 2, (i + 2) % 3);
                bf16_t* p = xb + RS_ROWOFF(i);
                float ssq_acc = 0.f;
#pragma unroll
                for (int bj = 0; bj < 2; ++bj) {
                    const u32x4 xw = xv[slot][bj];
                    const f32x4 xo0 = (f32x4){bf_lo(xw.x), bf_hi(xw.x), bf_lo(xw.y), bf_hi(xw.y)}, xo1 = (f32x4){bf_lo(xw.z), bf_hi(xw.z), bf_lo(xw.w), bf_hi(xw.w)};
                    const f32x4 x0 = xo0 + gt[bj][0] * acc[ai][bj][m][0], x1 = xo1 + gt[bj][1] * acc[ai][bj][m][1];
                    u32x4 xs; xs.x = cvt_pk(x0.x, x0.y); xs.y = cvt_pk(x0.z, x0.w); xs.z = cvt_pk(x1.x, x1.y); xs.w = cvt_pk(x1.z, x1.w);
                    *(u32x4*)(p + bj * HALF) = xs;
                    if (xg) {
                        ssq_acc += (x0.x * x0.x + x0.y * x0.y) + (x0.z * x0.z + x0.w * x0.w) + (x1.x * x1.x + x1.y * x1.y) + (x1.z * x1.z + x1.w * x1.w);
                        const f32x4 y0 = x0 * gn[bj][0], y1 = x1 * gn[bj][1];
                        u32x4 w; w.x = cvt_pk(y0.x, y0.y); w.y = cvt_pk(y0.z, y0.w); w.z = cvt_pk(y1.x, y1.y); w.w = cvt_pk(y1.z, y1.w);
                        const int row = trow0 + ai * HALF + wr * 64 + m * 16 + fr;
                        *(u32x4*)(xg + (size_t)row * DM + u.pn * BM + bj * HALF + colt) = w;
                    }
                }
                if (xg) { ssq_acc += sx<16>(ssq_acc); ssq_acc = sum32x(ssq_acc);
                    if (fq == 0) ((LAS float*)(elds + RING_BYTES))[wc * 256 + ai * HALF + wr * 64 + m * 16 + fr] = ssq_acc; }
            }
            if (xg) {
                LDS_WAIT(); __builtin_amdgcn_s_barrier();
                const int t = (wr * 4 + wc) * 64 + fq * 16 + fr;
                if (t < 256) { const LAS float* pp = (const LAS float*)(elds + RING_BYTES) + t; ssq_out[(size_t)(trow0 + t) * 4 + u.pn] = (pp[0] + pp[256]) + (pp[512] + pp[768]); }
            }
#undef RS_LOAD
#undef RS_ROWOFF
        } else if (mode == M_MOD || mode == M_SW) {
            if (wr == 0) {
#pragma unroll
                for (int m = 0; m < 3; ++m) {
                    const int row = m * 16 + fr;
                    if (row < NMODROW) {
#pragma unroll
                        for (int bj = 0; bj < 2; ++bj) {
                            const int cgl = u.pn * BM + bj * HALF + colt;
                            if (mode == M_SW) { float* o = modout + (size_t)row * 4096 + cgl; *(f32x4*)o = acc[0][bj][m][0]; *(f32x4*)(o + 4) = acc[0][bj][m][1]; }
                            else {
                                const int l = cgl / 6144, cc = cgl - l * 6144;
                                float* o = modout + ((size_t)(l * NMODROW + row)) * 6144 + cc;
                                const f32x4 b0 = *(const f32x4*)(bias + cgl), b1 = *(const f32x4*)(bias + cgl + 4);
                                const f32x4 v0 = acc[0][bj][m][0] + b0, v1 = acc[0][bj][m][1] + b1;
                                *(f32x4*)o = v0; *(f32x4*)(o + 4) = v1;
                                const int chunk = cc >> 10;
                                if (chunk == 0 || chunk == 3) {
                                    u32x4 w; w.x = cvt_pk(v0.x, v0.y); w.y = cvt_pk(v0.z, v0.w); w.z = cvt_pk(v1.x, v1.y); w.w = cvt_pk(v1.z, v1.w);
                                    *(u32x4*)(shiftout + ((size_t)((l * 2 + (chunk == 3 ? 1 : 0)) * 64 + row)) * 1024 + (cc & 1023)) = w;
                                }
                            }
                        }
                    }
                }
            }
        } else {
            float rstdv[8]; f32x4 swv[2][2];
            if (ssq) {
                const LAS unsigned char* pb = elds + RING_BYTES + 4096 + u.par * 5120;
#pragma unroll
                for (int bj = 0; bj < 2; ++bj) { swv[bj][0] = *(const LAS f32x4*)(pb + 4096 + (bj * HALF + colt) * 4); swv[bj][1] = *(const LAS f32x4*)(pb + 4096 + (bj * HALF + colt + 4) * 4); }
#pragma unroll
                for (int i = 0; i < 8; ++i) { const f32x4 q = *(const LAS f32x4*)(pb + ((i >> 2) * HALF + wr * 64 + (i & 3) * 16 + fr) * 16);
                    rstdv[i] = rsqrtf(((q.x + q.y) + (q.z + q.w)) * (1.f / DM) + EPS); }
            } else {
#pragma unroll
                for (int i = 0; i < 8; ++i) rstdv[i] = 1.f;
#pragma unroll
                for (int bj = 0; bj < 2; ++bj) { swv[bj][0] = (f32x4){0.f, 0.f, 0.f, 0.f}; swv[bj][1] = swv[bj][0]; }
            }
#define EP_V(I, BJ) float v[8]; { _Pragma("unroll") for (int e = 0; e < 4; ++e) { v[e] = acc[(I) >> 2][BJ][(I) & 3][0][e]; v[4 + e] = acc[(I) >> 2][BJ][(I) & 3][1][e]; } \
            if (ssq) { _Pragma("unroll") for (int e = 0; e < 4; ++e) { v[e] = fmaf(v[e], rstdv[I], swv[BJ][0][e]); v[4 + e] = fmaf(v[4 + e], rstdv[I], swv[BJ][1][e]); } } }
            if (mode == M_D1F) {
                const int N = ldc, Hh = N >> 1, t0 = u.pn * HALF + colt;
#pragma unroll
                for (int i = 0; i < 8; ++i) { const int rt = (i >> 2) * HALF + wr * 64 + (i & 3) * 16 + fr; const int cs = rt >> 7, l = rt & 127;
                    float o[8];
                    { EP_V(i, 0);
#pragma unroll
                        for (int e = 0; e < 8; ++e) o[e] = v[e]; }
                    { EP_V(i, 1);
#pragma unroll
                        for (int e = 0; e < 8; ++e) { const bool solo = (t0 == 0 && e == 0); o[e] = cs ? o[e] - v[e] : (solo ? o[e] : o[e] + v[e]); } }
                    bf16_t* dst = C + ((size_t)u.z * 128 + l) * N + (cs ? Hh : 0) + t0;
                    const u32x4 w = pack8(o);
                    if (cs && t0 == 0) {
                        unsigned short* d16 = (unsigned short*)dst; d16[1] = (unsigned short)(w.x >> 16); *(unsigned*)(d16 + 2) = w.y; *(unsigned*)(d16 + 4) = w.z; *(unsigned*)(d16 + 6) = w.w;
                    } else *(u32x4*)dst = w;
                }
            } else if (mode == M_FCIN) {
                const int pn = u.pn, trow0 = u.pm * BM;
                bf16_t* PF = (bf16_t*)(wsb + R_P); bf16_t* U = (bf16_t*)(wsb + R_U);
#pragma unroll
                for (int i = 0; i < 8; ++i) { const int row = trow0 + (i >> 2) * HALF + wr * 64 + (i & 3) * 16 + fr;
                    if (pn < 2) {
#pragma unroll
                        for (int bj = 0; bj < 2; ++bj) { EP_V(i, bj); const u32x4 w = pack8(v);
                            const int mrow = row < ML ? (row & ~2047) + ((2048 - (row & 2047)) & 2047) : ML + ((row - ML) & ~255) + ((256 - ((row - ML) & 255)) & 255);
                            *(u32x4*)(PF + (size_t)row * 512 + pn * BM + bj * HALF + colt) = w;
                            *(u32x4*)((bf16_t*)(wsb + R_PFM) + (size_t)mrow * 512 + pn * BM + bj * HALF + colt) = w; }
                    } else {
                        float av[8]; { EP_V(i, 0);
#pragma unroll
                            for (int e = 0; e < 8; ++e) av[e] = v[e]; }
                        { EP_V(i, 1);
#pragma unroll
                            for (int e = 0; e < 8; ++e) av[e] = av[e] / (1.f + __expf(-v[e])); }
                        *(u32x4*)(U + (size_t)row * 512 + (pn - 2) * HALF + colt) = pack8(av);
                    }
                }
            } else if (mode == M_QKV) {
                const int pn = u.pn, trow0 = u.pm * BM;
                bf16_t* CQ = (bf16_t*)(wsb + R_CQ); bf16_t* QG = (bf16_t*)(wsb + R_QG); bf16_t* CKV = (bf16_t*)(wsb + R_CKV);
                bf16_t* KG = (bf16_t*)(wsb + R_KG); bf16_t* VG = (bf16_t*)(wsb + R_VG); bf16_t* KR = (bf16_t*)(wsb + R_KR);
                if (pn == 2 || pn == 3 || pn == 5) {
                    LAS float* part2 = (LAS float*)(elds + RING_BYTES + 16384);
#pragma unroll
                    for (int i = 0; i < 8; ++i)
#pragma unroll
                        for (int bj = 0; bj < 2; ++bj) { EP_V(i, bj); float ss = 0.f;
#pragma unroll
                            for (int e = 0; e < 8; ++e) ss += v[e] * v[e];
                            ss += sx<16>(ss); ss = sum32x(ss);
                            if (fq == 0) part2[(bj * 4 + wc) * 256 + (i >> 2) * HALF + wr * 64 + (i & 3) * 16 + fr] = ss; }
                    LDS_WAIT(); __builtin_amdgcn_s_barrier();
                    const float* gh = (pn == 5 ? gkn : gqn) + 64 * (wc >> 1) + 32 * (fq >> 1) + 16 * (wc & 1) + 8 * (fq & 1);
                    const f32x4 g0 = *(const f32x4*)gh, g1 = *(const f32x4*)(gh + 4);
#pragma unroll
                    for (int i = 0; i < 8; ++i) { const int rt = (i >> 2) * HALF + wr * 64 + (i & 3) * 16 + fr, row = trow0 + rt;
                        const bool lat = row < ML; const int t = row & 2047;
                        bf16_t* dst = (pn == 5) ? KG + (size_t)kvrow_of(row) * 256 + colt : QG + (size_t)row * 512 + (pn - 2) * BM + colt;
                        float cs[8], sn[8]; rope_cs(cs, sn, wc >> 1, 16 * (wc & 1) + 8 * (fq & 1), 1.f / 32.f, t >> 6, t & 63);
#pragma unroll
                        for (int bj = 0; bj < 2; ++bj) { EP_V(i, bj);
                            const LAS float* pp = part2 + bj * 1024 + rt;
                            const float rh = rsqrtf(((pp[0] + pp[256]) + (pp[512] + pp[768])) * (1.f / 128.f) + EPS);
#pragma unroll
                            for (int e = 0; e < 4; ++e) { v[e] = v[e] * rh * g0[e]; v[4 + e] = v[4 + e] * rh * g1[e]; }
                            rope_apply32(v, cs, sn, fq < 2, lat);
                            *(u32x4*)(dst + bj * HALF) = pack8(v); } }
                } else if (pn == 7) {
#pragma unroll
                    for (int i = 0; i < 8; ++i) { const int row = trow0 + (i >> 2) * HALF + wr * 64 + (i & 3) * 16 + fr; const int t = row & 2047;
                        EP_V(i, 0);
                        rope8<32>(v, wc & 1, fq < 2, 8 * (fq & 1), 1.f / 16.f, t >> 6, t & 63, row < ML);
                        if (wc < 2) *(u32x4*)(KR + (size_t)kvrow_of(row) * 64 + colt) = pack8(v); }
                } else {
                    LAS float* part = (LAS float*)(elds + RING_BYTES);
#pragma unroll
                    for (int i = 0; i < 8; ++i) { const int rt = (i >> 2) * HALF + wr * 64 + (i & 3) * 16 + fr, row = trow0 + rt;
                        bf16_t* dst = pn < 2 ? CQ + (size_t)row * 512 + pn * BM + colt : (pn == 4 ? CKV + (size_t)row * 256 + colt : VG + (size_t)kvrow_of(row) * 256 + colt);
                        float ss = 0.f;
#pragma unroll
                        for (int bj = 0; bj < 2; ++bj) { EP_V(i, bj);
#pragma unroll
                            for (int e = 0; e < 8; ++e) ss += v[e] * v[e];
                            *(u32x4*)(dst + bj * HALF) = pack8(v); }
                        ss += sx<16>(ss); ss = sum32x(ss);
                        if (fq == 0) part[wc * 256 + rt] = ss; }
                    LDS_WAIT(); __builtin_amdgcn_s_barrier();
                    const int t = (wr * 4 + wc) * 64 + fq * 16 + fr;
                    if (t < 256 && pn != 6) { const LAS float* pp = part + t; const float sv = (pp[0] + pp[256]) + (pp[512] + pp[768]);
                        if (pn < 2) ssqc[(size_t)(trow0 + t) * 2 + pn] = sv; else ssqk[trow0 + t] = sv; }
                }
            } else {
            float r2v[8];
            if (mode == M_UQ) {
#pragma unroll
                for (int i = 0; i < 8; ++i) { const float* q = ssqc + (size_t)(u.pm * BM + (i >> 2) * HALF + wr * 64 + (i & 3) * 16 + fr) * 2; r2v[i] = q[0] + q[1]; }
#pragma unroll
                for (int i = 0; i < 8; ++i) r2v[i] = rsqrtf(r2v[i] * (1.f / 512.f) + EPS);
            } else if (mode == M_UKV) {
#pragma unroll
                for (int i = 0; i < 8; ++i) r2v[i] = ssqk[u.pm * BM + (i >> 2) * HALF + wr * 64 + (i & 3) * 16 + fr];
#pragma unroll
                for (int i = 0; i < 8; ++i) r2v[i] = rsqrtf(r2v[i] * (1.f / 256.f) + EPS);
            } else {
#pragma unroll
                for (int i = 0; i < 8; ++i) r2v[i] = 1.f;
            }
#pragma unroll
            for (int ai = 0; ai < 2; ++ai)
#pragma unroll
                for (int m = 0; m < 4; ++m) {
                    const int rt = ai * HALF + wr * 64 + m * 16 + fr;
                    const int row = u.pm * BM + rt;
                    bf16_t* dst; bool dorope = false; int prow = 0, pcol = 0;
                    if (mode == M_UQ) {
                        if (u.pn < 2) dst = C + (size_t)row * 512 + u.pn * BM;
                        else { dst = C2 + (size_t)row * 256; dorope = row < ML; const int t = row & 2047; prow = t >> 6; pcol = t & 63; }
                    } else if (mode == M_UKV) {
                        const int kr = kvrow_of(row);
                        dst = (u.pn < 2 ? C + u.pn * BM : C2 + (u.pn - 2) * BM) + (size_t)kr * 512;
                    } else {
                        const int rowv = u.pmz * BM + rt;
                        dst = C + (size_t)u.z * c_z + (size_t)(rowv & rmask) * ldc + (size_t)(rowv >> rshift) * rstep + u.pn * BM;
                    }
                    const float rstd = rstdv[ai * 4 + m];
                    float cs[8], sn[8];
                    if (mode == M_UQ && u.pn >= 2) rope_cs(cs, sn, wc & 1, (fq & 1) * 8, 1.f / 16.f, prow, pcol);
#pragma unroll
                    for (int bj = 0; bj < 2; ++bj) {
                        float v[8];
#pragma unroll
                        for (int e = 0; e < 4; ++e) { v[e] = acc[ai][bj][m][0][e]; v[4 + e] = acc[ai][bj][m][1][e]; }
                        if (ssq) {
#pragma unroll
                            for (int e = 0; e < 4; ++e) { v[e] = fmaf(v[e], rstd, swv[bj][0][e]); v[4 + e] = fmaf(v[4 + e], rstd, swv[bj][1][e]); }
                        }
                        if (mode == M_RELU2) {
#pragma unroll
                            for (int e = 0; e < 8; ++e) { const float r = fmaxf(v[e], 0.f); v[e] = r * r; }
                        }
                        if (mode == M_UQ || mode == M_UKV) { const float r2 = r2v[ai * 4 + m];
#pragma unroll
                            for (int e = 0; e < 8; ++e) v[e] *= r2; }
                        if (mode == M_UQ && u.pn >= 2) rope_apply32(v, cs, sn, fq < 2, dorope);
                        *(u32x4*)(dst + bj * HALF + colt) = pack8(v);
                    }
                }
            }
#undef EP_V
        }
    }
};

struct Gemm { int lda, ldb, K; size_t hstepB; };

#ifndef PG8_SP2
#define PG8_SP2 true
#endif
#ifndef PG8_ALIGN
#define PG8_ALIGN true
#endif
__device__ __forceinline__ void gemm_phase(LAS unsigned char* lds, const Gemm g, const Sched& S, const Epi& E, int wv) {
    constexpr bool SP2 = PG8_SP2, ALIGN_EPI = PG8_ALIGN;
    const int tid = otid(wv), wid = __builtin_amdgcn_readfirstlane(tid >> 6), lane = tid & 63, wr = wid >> 2, wc = wid & 3, fr = lane & 15, fq = lane >> 4;
    const int K = g.K, nt = K / BK;
    unsigned voffA[2], voffB[2];
#pragma unroll
    for (int i = 0; i < 2; ++i) { int R, C; stage_rc(tid * 16 + i * 8192, R, C); const int Rb = (R & ~31) + perm32(R & 31);
        voffA[i] = (unsigned)(R * g.lda + C) * 2u; voffB[i] = (unsigned)(Rb * g.ldb + C) * 2u; }
    const size_t kstep = (size_t)(BK * 2);
    const size_t hstepA = (size_t)HALF * g.lda * 2, hstepB = g.hstepB ? g.hstepB : (size_t)HALF * g.ldb * 2;
    const unsigned ldsw = (unsigned)wid * 1024u;
    const int aoff = lds_byte(wr * 64 + fr, fq * 8), boff = lds_byte(wc * 32 + fr, fq * 8);
#define PG8_SA(b, h) (((b) * 2 + (h)) * HTB)
#define PG8_SB(b, h) ((4 + (b) * 2 + (h)) * HTB)
#define PG8_STAGE(bufoff, gbase, voff) do { _Pragma("unroll") for (int _i = 0; _i < 2; ++_i) \
        __builtin_amdgcn_global_load_lds((const unsigned*)((const char*)(gbase) + (voff)[_i]), (LAS unsigned*)(lds + (bufoff) + ldsw + _i * 8192), 16, 0, 0); } while (0)
#define PG8_LDA(dst, b, h) do { _Pragma("unroll") for (int m = 0; m < 4; ++m) _Pragma("unroll") for (int k = 0; k < 2; ++k) dst[m][k] = *(const LAS bf16x8*)(lds + PG8_SA(b, h) + aoff + m * 2048 + k * 1024); } while (0)
#define PG8_LDB(dst, b, h) do { _Pragma("unroll") for (int n = 0; n < 2; ++n) _Pragma("unroll") for (int k = 0; k < 2; ++k) dst[n][k] = *(const LAS bf16x8*)(lds + PG8_SB(b, h) + boff + n * 2048 + k * 1024); } while (0)
#define PG8_MMA(ai, bj, At, Bt) do { __builtin_amdgcn_s_setprio(1); _Pragma("unroll") for (int m = 0; m < 4; ++m) _Pragma("unroll") for (int n = 0; n < 2; ++n) _Pragma("unroll") for (int k = 0; k < 2; ++k) \
        acc[ai][bj][m][n] = __builtin_amdgcn_mfma_f32_16x16x32_bf16(Bt[n][k], At[m][k], acc[ai][bj][m][n], 0, 0, 0); __builtin_amdgcn_s_setprio(0); } while (0)
#define PG8_PREF(U, PAR) do { if (E.ssq) { const int tr0_ = (U).pm * BM; \
        if (wid < 4) __builtin_amdgcn_global_load_lds((const unsigned*)(E.ssq + (size_t)tr0_ * 4 + (wid * 64 + lane) * 4), (LAS unsigned*)(lds + RING_BYTES + 4096 + (PAR) * 5120 + wid * 1024), 16, 0, 0); \
        else if (wid == 4) __builtin_amdgcn_global_load_lds((const unsigned*)(E.sw + (size_t)(tr0_ < ML ? (tr0_ >> 11) : 32) * 4096 + (U).pn * BM + lane * 4), (LAS unsigned*)(lds + RING_BYTES + 4096 + (PAR) * 5120 + 4096), 16, 0, 0); } } while (0)
#define PG8_WAIT_V(n) asm volatile("s_waitcnt vmcnt(" #n ")" ::: "memory")
#define PG8_WAIT_V_RX(f) asm volatile("s_cmp_eq_u32 %0, 0\n\ts_cbranch_scc1 1f\n\ts_waitcnt vmcnt(24)\n\ts_branch 2f\n1:\n\ts_waitcnt vmcnt(8)\n2:" :: "s"(f) : "scc", "memory")
#define PG8_WAIT_L(n) asm volatile("s_waitcnt lgkmcnt(" #n ")" ::: "memory")
#define PG8_BAR __builtin_amdgcn_s_barrier()
#define PG8_SCHED __builtin_amdgcn_sched_barrier(0)
    Unit cur, nxt; int ui = 0;
    if (!S.next(0, cur)) return;
    const bool relax = (E.mode != M_MOD && E.mode != M_SW && E.mode != M_QKV && E.mode != M_FCIN && E.mode != M_D1F);
    f32x4 acc[2][2][4][2];
#pragma unroll
    for (int a = 0; a < 2; ++a)
#pragma unroll
        for (int b = 0; b < 2; ++b)
#pragma unroll
            for (int m = 0; m < 4; ++m)
#pragma unroll
                for (int n = 0; n < 2; ++n) acc[a][b][m][n] = (f32x4){0.f, 0.f, 0.f, 0.f};
    bf16x8 At[4][2], B0[2][2], B1[2][2];
    const char* cA = cur.A; const char* cB = cur.B;
    cur.par = 0; PG8_PREF(cur, 0);
    if constexpr (SP2) {
        PG8_STAGE(PG8_SB(0, 0), cB, voffB); PG8_STAGE(PG8_SB(0, 1), cB + hstepB, voffB); PG8_STAGE(PG8_SA(0, 0), cA, voffA); PG8_STAGE(PG8_SA(0, 1), cA + hstepA, voffA);
        if (wr == 1) PG8_BAR;
        PG8_WAIT_V(2); PG8_BAR;
        PG8_STAGE(PG8_SB(1, 0), cB + kstep, voffB); PG8_STAGE(PG8_SA(1, 0), cA + kstep, voffA); PG8_STAGE(PG8_SB(1, 1), cB + hstepB + kstep, voffB);
        PG8_WAIT_V(6); PG8_BAR;
    } else {
    PG8_STAGE(PG8_SB(0, 0), cB, voffB); PG8_STAGE(PG8_SA(0, 0), cA, voffA); PG8_STAGE(PG8_SB(0, 1), cB + hstepB, voffB); PG8_STAGE(PG8_SA(0, 1), cA + hstepA, voffA);
    if (wr == 1) PG8_BAR;
    PG8_WAIT_V(4); PG8_BAR;
    PG8_STAGE(PG8_SB(1, 0), cB + kstep, voffB); PG8_STAGE(PG8_SA(1, 0), cA + kstep, voffA); PG8_STAGE(PG8_SB(1, 1), cB + hstepB + kstep, voffB);
    PG8_WAIT_V(6); PG8_BAR;
    }
    for (;;) {
        const bool has_next = S.next(ui + 1, nxt);
        const char* nA = has_next ? nxt.A : cA; const char* nB = has_next ? nxt.B : cB;
        for (int t = 0; t < nt; t += 2) {
            const bool last = (t == nt - 2);
            const char* a1 = cA + (size_t)(t + 1) * kstep;
            const char* a2 = last ? nA : cA + (size_t)(t + 2) * kstep; const char* b2 = last ? nB : cB + (size_t)(t + 2) * kstep;
            const char* a3 = a2 + kstep; const char* b3 = b2 + kstep;
            if constexpr (SP2) {
            const int rx = __builtin_amdgcn_readfirstlane((relax && ui > 0 && t == 0) ? 1 : 0);
            PG8_LDB(B0, 0, 0); PG8_LDB(B1, 0, 1); PG8_SCHED; PG8_LDA(At, 0, 0); PG8_STAGE(PG8_SA(1, 1), a1 + hstepA, voffA);
            PG8_WAIT_V_RX(rx);
            PG8_WAIT_L(0); PG8_BAR; PG8_MMA(0, 0, At, B0); PG8_MMA(0, 1, At, B1); PG8_BAR; PG8_SCHED;
            PG8_LDA(At, 0, 1); PG8_STAGE(PG8_SB(0, 0), b2, voffB); PG8_STAGE(PG8_SB(0, 1), b2 + hstepB, voffB); PG8_STAGE(PG8_SA(0, 0), a2, voffA);
            PG8_WAIT_V_RX(rx);
            PG8_WAIT_L(0); PG8_BAR; PG8_MMA(1, 0, At, B0); PG8_MMA(1, 1, At, B1); PG8_BAR; PG8_SCHED;
            PG8_LDB(B0, 1, 0); PG8_LDB(B1, 1, 1); PG8_SCHED; PG8_LDA(At, 1, 0); PG8_STAGE(PG8_SA(0, 1), a2 + hstepA, voffA);
            PG8_WAIT_V(8); PG8_WAIT_L(0); PG8_BAR; PG8_MMA(0, 0, At, B0); PG8_MMA(0, 1, At, B1); PG8_BAR; PG8_SCHED;
            PG8_LDA(At, 1, 1); PG8_STAGE(PG8_SB(1, 0), b3, voffB); PG8_STAGE(PG8_SB(1, 1), b3 + hstepB, voffB); PG8_STAGE(PG8_SA(1, 0), a3, voffA);
            PG8_WAIT_V(8); PG8_WAIT_L(0); PG8_BAR; PG8_MMA(1, 0, At, B0); PG8_MMA(1, 1, At, B1); PG8_BAR; PG8_SCHED;
            } else {
            PG8_LDB(B0, 0, 0); PG8_SCHED; PG8_LDA(At, 0, 0); PG8_STAGE(PG8_SA(1, 1), a1 + hstepA, voffA);
            PG8_WAIT_L(8); PG8_BAR; PG8_WAIT_L(0); PG8_MMA(0, 0, At, B0); PG8_BAR; PG8_SCHED;
            PG8_LDB(B1, 0, 1); PG8_STAGE(PG8_SB(0, 0), b2, voffB);
            PG8_BAR; PG8_WAIT_L(0); PG8_MMA(0, 1, At, B1); PG8_BAR;
            PG8_LDA(At, 0, 1); PG8_STAGE(PG8_SA(0, 0), a2, voffA);
            PG8_BAR; PG8_WAIT_L(0); PG8_MMA(1, 0, At, B0); PG8_BAR; PG8_SCHED;
            PG8_STAGE(PG8_SB(0, 1), b2 + hstepB, voffB);
            PG8_WAIT_V(6); PG8_BAR; PG8_MMA(1, 1, At, B1); PG8_BAR;
            PG8_LDB(B0, 1, 0); PG8_SCHED; PG8_LDA(At, 1, 0); PG8_STAGE(PG8_SA(0, 1), a2 + hstepA, voffA);
            PG8_WAIT_L(8); PG8_BAR; PG8_WAIT_L(0); PG8_MMA(0, 0, At, B0); PG8_BAR; PG8_SCHED;
            PG8_LDB(B1, 1, 1); PG8_STAGE(PG8_SB(1, 0), b3, voffB);
            PG8_BAR; PG8_WAIT_L(0); PG8_MMA(0, 1, At, B1); PG8_BAR;
            PG8_LDA(At, 1, 1); PG8_STAGE(PG8_SA(1, 0), a3, voffA);
            PG8_BAR; PG8_WAIT_L(0); PG8_MMA(1, 0, At, B0); PG8_BAR; PG8_SCHED;
            PG8_STAGE(PG8_SB(1, 1), b3 + hstepB, voffB);
            PG8_WAIT_V(6); PG8_BAR; PG8_MMA(1, 1, At, B1); PG8_BAR;
            }
        }
        if constexpr (ALIGN_EPI) { if (wr == 0) PG8_BAR; }
        { const int l2 = otid(wv) & 63; E(acc, cur, wr, wc, l2 & 15, l2 >> 4); }
        if (!has_next) break;
#pragma unroll
        for (int a = 0; a < 2; ++a)
#pragma unroll
            for (int b = 0; b < 2; ++b)
#pragma unroll
                for (int m = 0; m < 4; ++m)
#pragma unroll
                    for (int n = 0; n < 2; ++n) acc[a][b][m][n] = (f32x4){0.f, 0.f, 0.f, 0.f};
        cur = nxt; cA = nA; cB = nB; ++ui;
        cur.par = ui & 1; PG8_PREF(cur, ui & 1);
        if constexpr (ALIGN_EPI) { if (wr == 1) PG8_BAR; }
    }
    PG8_WAIT_V(0);
    if constexpr (!ALIGN_EPI) { if (wr == 0) PG8_BAR; }
    PG8_BAR;
#undef PG8_SA
#undef PG8_SB
#undef PG8_STAGE
#undef PG8_LDA
#undef PG8_LDB
#undef PG8_MMA
#undef PG8_WAIT_V
#undef PG8_PREF
#undef PG8_WAIT_V_RX
#undef PG8_WAIT_L
#undef PG8_BAR
#undef PG8_SCHED
}
}

namespace att {
constexpr int QBLK = 32, KVBLK = 64;
constexpr int SHM_V = 16384, SHM_K = 16384, SHM_K2 = 8192;
constexpr int OFF_V = 0, OFF_K = 32768, OFF_K2 = 65536, OFF_WS = 81920, OFF_Q2 = 86016;
#define KSWZ(row, colB) ((row) * 256 + ((colB) ^ (((row) & 7) << 4)))
#define K2SWZ(row, colB) ((row) * 128 + ((colB) ^ ((((row) >> 1) & 7) << 4)))
#define SBAR() __builtin_amdgcn_sched_barrier(0)
__device__ __forceinline__ int crow(int r, int hi) { return (r & 3) + 8 * (r >> 2) + 4 * hi; }

struct Job { const bf16_t* Q; const bf16_t* Q2; const bf16_t* K; const bf16_t* K2; const bf16_t* V; bf16_t* O; int ldq, ldq2, ldk, ldo, seq; float scale; int rope; };

__device__ __forceinline__ void partialSM(f32x16& p0, f32x16& p1, float& m_reg, float& mn, float& alpha, float C, float thr) {
    float pmax = p0[0];
#pragma unroll
    for (int r = 1; r < 16; ++r) pmax = fmaxf(pmax, p0[r]);
#pragma unroll
    for (int r = 0; r < 16; ++r) pmax = fmaxf(pmax, p1[r]);
    { auto rr = __builtin_amdgcn_permlane32_swap(__float_as_uint(pmax), __float_as_uint(pmax), false, false);
      pmax = fmaxf(__uint_as_float(rr[0]), __uint_as_float(rr[1])); }
    if (__builtin_expect(__all(pmax - m_reg <= thr), 1)) { mn = m_reg; alpha = 1.f; }
    else { mn = fmaxf(m_reg, pmax); alpha = __builtin_amdgcn_exp2f((m_reg - mn) * C); m_reg = mn; }
    const float mnC = -mn * C;
#pragma unroll
    for (int r = 0; r < 16; ++r) p0[r] = fmaf(p0[r], C, mnC);
#pragma unroll
    for (int r = 0; r < 16; ++r) p1[r] = fmaf(p1[r], C, mnC);
#pragma unroll
    for (int r = 0; r < 16; ++r) p0[r] = __builtin_amdgcn_exp2f(p0[r]);
}
__device__ __forceinline__ void finishSM(f32x16& p0, f32x16& p1, float alpha, float& l_reg, bf16x8& pa0, bf16x8& pa1, bf16x8& pa2, bf16x8& pa3) {
#pragma unroll
    for (int r = 0; r < 16; ++r) p1[r] = __builtin_amdgcn_exp2f(p1[r]);
    float ps = 0;
#pragma unroll
    for (int r = 0; r < 16; ++r) ps += p0[r];
#pragma unroll
    for (int r = 0; r < 16; ++r) ps += p1[r];
    { auto rr = __builtin_amdgcn_permlane32_swap(__float_as_uint(ps), __float_as_uint(ps), false, false);
      ps = __uint_as_float(rr[0]) + __uint_as_float(rr[1]); }
    l_reg = l_reg * alpha + ps;
#define PK4(P, BASE, OUT) do { unsigned a0 = cvt_pk(P[BASE + 0], P[BASE + 1]), a1 = cvt_pk(P[BASE + 2], P[BASE + 3]);   \
    unsigned b0 = cvt_pk(P[BASE + 4], P[BASE + 5]), b1 = cvt_pk(P[BASE + 6], P[BASE + 7]);                              \
    auto r0 = __builtin_amdgcn_permlane32_swap(a0, b0, false, false); auto r1 = __builtin_amdgcn_permlane32_swap(a1, b1, false, false); \
    u32x4 w = {r0[0], r1[0], r0[1], r1[1]}; OUT = *reinterpret_cast<bf16x8*>(&w); } while (0)
    PK4(p0, 0, pa0); PK4(p0, 8, pa1); PK4(p1, 0, pa2); PK4(p1, 8, pa3);
#undef PK4
}
template <bool ROPE> __device__ __forceinline__ void qkt(f32x16& p0, f32x16& p1, const char* Ks, const char* K2s, const bf16x8* qr, const char* q2s, int r32, int hi) {
    p0 = f32x16{}; p1 = f32x16{};
#pragma unroll
    for (int d0 = 0; d0 < 8; ++d0) { const int cb = (d0 * 16 + hi * 8) * 2;
        const bf16x8 b0 = *reinterpret_cast<const bf16x8*>(Ks + KSWZ(r32, cb));
        const bf16x8 b1 = *reinterpret_cast<const bf16x8*>(Ks + KSWZ(32 + r32, cb));
        bf16x8 q; if (!ROPE || d0 < 4) q = qr[d0]; else q = *reinterpret_cast<const bf16x8*>(q2s + d0 * 1024);
        p0 = __builtin_amdgcn_mfma_f32_32x32x16_bf16(b0, q, p0, 0, 0, 0);
        p1 = __builtin_amdgcn_mfma_f32_32x32x16_bf16(b1, q, p1, 0, 0, 0); }
    if (ROPE) {
#pragma unroll
        for (int d0 = 0; d0 < 4; ++d0) { const int cb = (d0 * 16 + hi * 8) * 2;
            const bf16x8 b0 = *reinterpret_cast<const bf16x8*>(K2s + K2SWZ(r32, cb));
            const bf16x8 b1 = *reinterpret_cast<const bf16x8*>(K2s + K2SWZ(32 + r32, cb));
            const bf16x8 q2 = *reinterpret_cast<const bf16x8*>(q2s + d0 * 1024);
            p0 = __builtin_amdgcn_mfma_f32_32x32x16_bf16(b0, q2, p0, 0, 0, 0);
            p1 = __builtin_amdgcn_mfma_f32_32x32x16_bf16(b1, q2, p1, 0, 0, 0); }
    }
}
__device__ __forceinline__ int v_st(int k, int c) { const int kk = (k & ~0xC) | ((k & 4) << 1) | ((k & 8) >> 1); return ((kk >> 3) * 4 + (c >> 5)) * 512 + ((kk & 7) * 32 + (c & 31)) * 2; }
__device__ __forceinline__ int v_rd_base(int lane) { return ((lane & 3) << 3) | (((lane >> 2) & 3) << 6) | (((lane >> 4) & 1) << 5) | (((lane >> 5) & 1) << 8); }
constexpr int v_rd_off(int d0, int ks, int half) { return d0 * 512 + ks * 4096 + half * 2048; }
template <int OFF> __device__ __forceinline__ s16x4 tr_read(int vb) {
    s16x4 r; asm volatile("ds_read_b64_tr_b16 %0, %1 offset:%2" : "=&v"(r) : "v"(vb), "i"(OFF) : "memory"); return r;
}
template <int D0> __device__ __forceinline__ void pv_one(f32x16& od, int vb, bf16x8 pa0, bf16x8 pa1, bf16x8 pa2, bf16x8 pa3) {
    const s16x4 l0 = tr_read<v_rd_off(D0, 0, 0)>(vb), h0 = tr_read<v_rd_off(D0, 0, 1)>(vb), l1 = tr_read<v_rd_off(D0, 1, 0)>(vb), h1 = tr_read<v_rd_off(D0, 1, 1)>(vb);
    const s16x4 l2 = tr_read<v_rd_off(D0, 2, 0)>(vb), h2 = tr_read<v_rd_off(D0, 2, 1)>(vb), l3 = tr_read<v_rd_off(D0, 3, 0)>(vb), h3 = tr_read<v_rd_off(D0, 3, 1)>(vb);
    asm volatile("s_waitcnt lgkmcnt(0)" ::: "memory"); SBAR();
#define PK(L, H) (bf16x8){L[0], L[1], L[2], L[3], H[0], H[1], H[2], H[3]}
    od = __builtin_amdgcn_mfma_f32_32x32x16_bf16(pa0, PK(l0, h0), od, 0, 0, 0);
    od = __builtin_amdgcn_mfma_f32_32x32x16_bf16(pa1, PK(l1, h1), od, 0, 0, 0);
    od = __builtin_amdgcn_mfma_f32_32x32x16_bf16(pa2, PK(l2, h2), od, 0, 0, 0);
    od = __builtin_amdgcn_mfma_f32_32x32x16_bf16(pa3, PK(l3, h3), od, 0, 0, 0);
#undef PK
}
__device__ __forceinline__ void pv_d0(f32x16* o, int vb, bf16x8 pa0, bf16x8 pa1, bf16x8 pa2, bf16x8 pa3) {
    pv_one<0>(o[0], vb, pa0, pa1, pa2, pa3); pv_one<1>(o[1], vb, pa0, pa1, pa2, pa3); pv_one<2>(o[2], vb, pa0, pa1, pa2, pa3); pv_one<3>(o[3], vb, pa0, pa1, pa2, pa3);
}

template <bool ROPE> __device__ __forceinline__ void attn_unit(const Job& J, char* lds, int wv) {
    const int tid = otid(wv), wid = tid >> 6, lane = tid & 63, r32 = lane & 31, hi = lane >> 5;
    char* V_lds = lds + OFF_V; char* K_lds = lds + OFF_K; char* K2_lds = lds + OFF_K2;
    float* ws = (float*)(lds + OFF_WS) + wid * 64; float* li_l = ws; float* al_l = ws + 32;
    const float C = J.scale * 1.4426950408889634f, thr = 8.f / J.scale;
    constexpr int rope = ROPE ? 1 : 0;
    float m_reg = -1e30f, l_reg = 0; f32x16 o[4] = {}; bf16x8 qr[ROPE ? 4 : 8];
    char* q2s = lds + OFF_Q2 + wid * 8192 + lane * 16;
    const bf16_t* Qw = J.Q + (long)(wid * QBLK + r32) * J.ldq + hi * 8;
#pragma unroll
    for (int d0 = 0; d0 < 4; ++d0) qr[d0] = *reinterpret_cast<const bf16x8*>(Qw + d0 * 16);
#pragma unroll
    for (int d0 = 4; d0 < 8; ++d0) { if constexpr (ROPE) *reinterpret_cast<bf16x8*>(q2s + d0 * 1024) = *reinterpret_cast<const bf16x8*>(Qw + d0 * 16); else qr[d0] = *reinterpret_cast<const bf16x8*>(Qw + d0 * 16); }
    if (rope) {
        const bf16_t* Q2w = J.Q2 + (long)(wid * QBLK + r32) * J.ldq2 + hi * 8;
#pragma unroll
        for (int d0 = 0; d0 < 4; ++d0) *reinterpret_cast<bf16x8*>(q2s + d0 * 1024) = *reinterpret_cast<const bf16x8*>(Q2w + d0 * 16);
    }
    const int sr = tid >> 4, sc = (tid & 15) * 8, vst0 = v_st(sr, sc), vst1 = v_st(32 + sr, sc);
    const int s2r = tid >> 3, s2c = (tid & 7) * 8;
    const int vb0 = (int)(uintptr_t)V_lds + v_rd_base(lane);
    const bf16_t* Kh = J.K; const bf16_t* Vh = J.V; const bf16_t* K2h = J.K2; const int LDK = J.ldk;
    bf16x8 vs0, vs1, ks0, ks1, k2s;
#define SLOAD(k0) do { vs0 = *reinterpret_cast<const bf16x8*>(&Vh[(long)((k0) + sr) * LDK + sc]); vs1 = *reinterpret_cast<const bf16x8*>(&Vh[(long)((k0) + 32 + sr) * LDK + sc]); \
    ks0 = *reinterpret_cast<const bf16x8*>(&Kh[(long)((k0) + sr) * LDK + sc]); ks1 = *reinterpret_cast<const bf16x8*>(&Kh[(long)((k0) + 32 + sr) * LDK + sc]); \
    if (rope) k2s = *reinterpret_cast<const bf16x8*>(&K2h[(long)((k0) + s2r) * 64 + s2c]); } while (0)
#define SWRITE(b) do { *(bf16x8*)(V_lds + (b) * SHM_V + vst0) = vs0; *(bf16x8*)(V_lds + (b) * SHM_V + vst1) = vs1; const int kc = sc * 2; \
    *(bf16x8*)(K_lds + (b) * SHM_K + KSWZ(sr, kc)) = ks0; *(bf16x8*)(K_lds + (b) * SHM_K + KSWZ(32 + sr, kc)) = ks1; \
    if (rope) *(bf16x8*)(K2_lds + (b) * SHM_K2 + K2SWZ(s2r, s2c * 2)) = k2s; } while (0)
#define SWAIT() asm volatile("s_waitcnt vmcnt(0)" ::: "memory")
#define RESC(a) do { if (__any((a) < 1.f)) { if (hi == 0) al_l[r32] = (a); asm volatile("s_waitcnt lgkmcnt(0)" ::: "memory"); \
    _Pragma("unroll") for (int d = 0; d < 4; ++d) _Pragma("unroll") for (int r = 0; r < 16; ++r) o[d][r] *= al_l[crow(r, hi)]; } } while (0)
    f32x16 pA0, pA1, pB0, pB1; float mnA, mnB, alA, alB; bf16x8 pa0, pa1, pa2, pa3; const int NT = J.seq / KVBLK;
    SLOAD(0); SWAIT(); SWRITE(0); __syncthreads();
    qkt<ROPE>(pA0, pA1, K_lds, K2_lds, qr, q2s, r32, hi); partialSM(pA0, pA1, m_reg, mnA, alA, C, thr);
    SLOAD(KVBLK);
    SWAIT(); SWRITE(1); __syncthreads();
    for (int j = 1; j + 1 < NT; j += 2) {
        SBAR(); qkt<ROPE>(pB0, pB1, K_lds + SHM_K, K2_lds + SHM_K2, qr, q2s, r32, hi);
        finishSM(pA0, pA1, alA, l_reg, pa0, pa1, pa2, pa3); SBAR();
        SLOAD((j + 1) * KVBLK); SBAR();
        pv_d0(o, vb0, pa0, pa1, pa2, pa3); partialSM(pB0, pB1, m_reg, mnB, alB, C, thr);
        __syncthreads(); SWAIT(); SWRITE(0);
        RESC(alB); __syncthreads();
        SBAR(); qkt<ROPE>(pA0, pA1, K_lds, K2_lds, qr, q2s, r32, hi);
        finishSM(pB0, pB1, alB, l_reg, pa0, pa1, pa2, pa3); SBAR();
        SLOAD((j + 2) * KVBLK); SBAR();
        pv_d0(o, vb0 + SHM_V, pa0, pa1, pa2, pa3); partialSM(pA0, pA1, m_reg, mnA, alA, C, thr);
        __syncthreads(); SWAIT(); SWRITE(1);
        RESC(alA); __syncthreads();
    }
    SBAR(); qkt<ROPE>(pB0, pB1, K_lds + SHM_K, K2_lds + SHM_K2, qr, q2s, r32, hi);
    finishSM(pA0, pA1, alA, l_reg, pa0, pa1, pa2, pa3); SBAR();
    pv_d0(o, vb0, pa0, pa1, pa2, pa3); partialSM(pB0, pB1, m_reg, mnB, alB, C, thr);
    __syncthreads(); RESC(alB);
    finishSM(pB0, pB1, alB, l_reg, pa0, pa1, pa2, pa3); SBAR();
    pv_d0(o, vb0 + SHM_V, pa0, pa1, pa2, pa3);
    if (hi == 0) li_l[r32] = l_reg; asm volatile("s_waitcnt lgkmcnt(0)" ::: "memory");
    float rli[16];
#pragma unroll
    for (int r = 0; r < 16; ++r) rli[r] = __builtin_amdgcn_rcpf(li_l[crow(r, hi)]);
    bf16_t* Ow = J.O + (long)(wid * QBLK) * J.ldo;
    char* ost = lds + OFF_Q2 + wid * 8192;
#pragma unroll
    for (int r = 0; r < 16; ++r) { const int orow = crow(r, hi);
#pragma unroll
        for (int d0 = 0; d0 < 4; ++d0) *(bf16_t*)(ost + orow * 256 + (d0 * 32 + r32) * 2) = (bf16_t)(cvt_pk(o[d0][r] * rli[r], 0.f) & 0xffffu); }
    asm volatile("s_waitcnt lgkmcnt(0)" ::: "memory");
#pragma unroll
    for (int k = 0; k < 8; ++k) { const int p = lane + 64 * k, row = p >> 4, c16 = p & 15;
        *(u32x4*)(Ow + (long)row * J.ldo + c16 * 8) = *(const u32x4*)(ost + row * 256 + c16 * 16); }
#undef SLOAD
#undef SWRITE
#undef SWAIT
#undef RESC
}
}

struct Args { const float* in[25]; float* out; unsigned char* ws; int ph_lo, ph_hi; };
__device__ __forceinline__ int oidx(int i) { asm volatile("" : "+s"(i)); return i; }
enum { I_X = 0, I_C, I_CTX, I_CCTX, I_MODW, I_MODB, I_N1G, I_N2G, I_AWIN, I_QNG, I_WUQ, I_KVNG, I_WUKV, I_GQNG, I_GKNG, I_AWOUT, I_FCWIN, I_CONVW, I_CONVB, I_LNG, I_LNB, I_FCWOUT, I_W1, I_W2, I_FING };

__device__ __forceinline__ int src_col(int kind, int n) {
    if (kind == 1) {
        if ((n >= 512 && n < 1024) || (n >= 1280 && n < 1536)) { const int b0 = n < 1024 ? 512 : 1280, sb = n < 1024 ? 512 : 1344, h = (n - b0) >> 7, c = (n - b0) & 127;
            const int wc = c >> 5, fq = (c >> 3) & 3, e = c & 7; return sb + h * 128 + 64 * (wc >> 1) + 32 * (fq >> 1) + 16 * (wc & 1) + 8 * (fq & 1) + e; }
        if (n < 1280) return n; if (n < 1792) return n + 64; if (n < 1856) return n - 512; return -1; }
    if (kind == 4) { if (n < 512) return n; const int c = n - 512, j = c >> 8, r = c & 255; return r < 128 ? 512 + 128 * j + r : 1024 + 128 * j + (r - 128); }
    if (kind == 2) { if (n < 512) return (n >> 7) * 192 + (n & 127); const int c = n - 512; return (c >> 6) * 192 + 128 + (c & 63); }
    if (kind == 3) { if (n < 512) return (n >> 7) * 256 + (n & 127); const int c = n - 512; return (c >> 7) * 256 + 128 + (c & 127); }
    return n;
}
__device__ __forceinline__ void transpose_item(const float* W, int K, int Nsrc, int Ndst, bf16_t* WT, int kind, const float* rscale, LAS float* scr, int item, int lane) {
    const int nblk = Ndst / 64, kb = item / nblk, nb = item - kb * nblk, k0 = 64 * kb, n0 = 64 * nb;
    const int kr = lane >> 4, n4 = (lane & 15) * 4;
    const int s0 = src_col(kind, n0 + n4);
    f32x4 v[16];
#pragma unroll
    for (int i = 0; i < 16; ++i) v[i] = s0 >= 0 ? __builtin_nontemporal_load((const f32x4*)(W + (size_t)(k0 + 4 * i + kr) * Nsrc + s0)) : (f32x4){0.f, 0.f, 0.f, 0.f};
    if (rscale) {
#pragma unroll
        for (int i = 0; i < 16; ++i) v[i] = v[i] * rscale[k0 + 4 * i + kr]; }
#pragma unroll
    for (int i = 0; i < 16; ++i) { LAS float* d = scr + (4 * i + kr) * 65 + n4; d[0] = v[i].x; d[1] = v[i].y; d[2] = v[i].z; d[3] = v[i].w; }
    LDS_WAIT(); asm volatile("" ::: "memory");
    const int c = lane & 7, nn = lane >> 3;
#pragma unroll
    for (int j = 0; j < 8; ++j) { const int n = nn + 8 * j; const LAS float* sp = scr + (8 * c) * 65 + n;
        u32x4 o; o.x = cvt_pk(sp[0 * 65], sp[1 * 65]); o.y = cvt_pk(sp[2 * 65], sp[3 * 65]); o.z = cvt_pk(sp[4 * 65], sp[5 * 65]); o.w = cvt_pk(sp[6 * 65], sp[7 * 65]);
        *(u32x4*)(WT + (size_t)(n0 + n) * K + k0 + 8 * c) = o; }
    LDS_WAIT(); asm volatile("" ::: "memory");
}
struct WDesc { const float* W; bf16_t* WT; const float* rscale; int K, Nsrc, Ndst, kind; };
__device__ __forceinline__ WDesc wdesc(const Args& a, unsigned char* wsl, float* outl, int d) {
    WDesc w; unsigned char* ws = wsl; w.rscale = nullptr;
    if (d < 4) { w.W = a.in[oidx(I_MODW)] + (size_t)d * 1024 * 6144; w.WT = (bf16_t*)(ws + R_MODWT) + (size_t)d * 6144 * 1024; w.K = 1024; w.Nsrc = 6144; w.Ndst = 6144; w.kind = 0; return w; }
    d -= 4;
    if (d < 4) { w.W = a.in[oidx(I_W1)] + (size_t)d * 1024 * 4096; w.WT = (bf16_t*)(ws + WS_W1) + (size_t)d * 4096 * 1024; w.K = 1024; w.Nsrc = 4096; w.Ndst = 4096; w.kind = 0; return w; }
    d -= 4;
    if (d < 4) { w.W = a.in[oidx(I_W2)] + (size_t)d * 4096 * 1024; w.WT = (bf16_t*)(ws + WS_W2) + (size_t)d * 1024 * 4096; w.K = 4096; w.Nsrc = 1024; w.Ndst = 1024; w.kind = 0; return w; }
    d -= 4;
    const int j = d & 1, k = d >> 1;
    switch (k) {
        case 0: w.W = a.in[oidx(I_AWIN)] + (size_t)j * 1024 * 1856; w.WT = (bf16_t*)(ws + WS_WIN) + (size_t)j * 2048 * 1024; w.K = 1024; w.Nsrc = 1856; w.Ndst = 2048; w.kind = 1; break;
        case 1: w.W = a.in[oidx(I_WUQ)] + (size_t)j * 512 * 768; w.WT = (bf16_t*)(ws + WS_UQ) + (size_t)j * 768 * 512; w.K = 512; w.Nsrc = 768; w.Ndst = 768; w.kind = 2; w.rscale = a.in[oidx(I_QNG)] + j * 512; break;
        case 2: w.W = a.in[oidx(I_WUKV)] + (size_t)j * 256 * 1024; w.WT = (bf16_t*)(ws + WS_UKV) + (size_t)j * 1024 * 256; w.K = 256; w.Nsrc = 1024; w.Ndst = 1024; w.kind = 3; w.rscale = a.in[oidx(I_KVNG)] + j * 256; break;
        case 3: w.W = a.in[oidx(I_AWOUT)] + (size_t)j * 1024 * 1024; w.WT = (bf16_t*)(ws + WS_AOUT) + (size_t)j * 1024 * 1024; w.K = 1024; w.Nsrc = 1024; w.Ndst = 1024; w.kind = 0; break;
        case 4: w.W = a.in[oidx(I_FCWIN)] + (size_t)j * 1024 * 1536; w.WT = (bf16_t*)(ws + WS_FCIN) + (size_t)j * 1536 * 1024; w.K = 1024; w.Nsrc = 1536; w.Ndst = 1536; w.kind = 4; break;
        default: w.W = a.in[oidx(I_FCWOUT)] + (size_t)j * 1024 * 1024; w.WT = (bf16_t*)(ws + WS_FCOUT) + (size_t)j * 1024 * 1024; w.K = 1024; w.Nsrc = 1024; w.Ndst = 1024; w.kind = 0; break;
    }
    return w;
}
__device__ __forceinline__ void setup_phase(const Args& a, unsigned char* wsl, float* outl, LAS unsigned char* lds, int wv) {
    const int tid = otid(wv), lane = tid & 63, wave = tid >> 6;
    const int gw = blockIdx.x * NWAVES + wave, NGW = gridDim.x * NWAVES;
    LAS float* scr = (LAS float*)(lds + wave * 16896);
    for (int d = 0; d < 24; ++d) {
        const WDesc w = wdesc(a, wsl, outl, d);
        const int nitems = (w.K / 64) * (w.Ndst / 64);
        for (int it = gw; it < nitems; it += NGW) transpose_item(w.W, w.K, w.Nsrc, w.Ndst, w.WT, w.kind, w.rscale, scr, it, lane);
    }
    const int gt = blockIdx.x * NTHREADS + tid, NGT = gridDim.x * NTHREADS;
    { bf16_t* A2 = (bf16_t*)(wsl + WS_A2); const float sc = 0.022097086912079608f;
      for (int i = gt; i < 2048 * 2048 / 8; i += NGT) { const int k = i >> 8, c0 = (i & 255) * 8; float v[8];
#pragma unroll
          for (int e = 0; e < 8; ++e) { const int c = c0 + e, t = c <= 1024 ? c : c - 1024; const int r = (k * t) & 2047; const float x = (float)(2 * r) * (1.f / 2048.f);
              v[e] = (c <= 1024 ? cospif(x) : -sinpif(x)) * sc; }
          *(u32x4*)(A2 + (size_t)i * 8) = pack8(v); } }
    { bf16_t* A2c = (bf16_t*)(wsl + WS_A2C);
      for (int i = gt; i < 256 * 256 / 8; i += NGT) { const int k = i >> 5, c0 = (i & 31) * 8; float v[8];
#pragma unroll
          for (int e = 0; e < 8; ++e) { const int c = c0 + e, t = c <= 128 ? c : c - 128; const int r = (k * t) & 255; const float x = (float)(2 * r) * (1.f / 256.f);
              v[e] = (c <= 128 ? cospif(x) : -sinpif(x)) * 0.0625f; }
          *(u32x4*)(A2c + (size_t)i * 8) = pack8(v); } }
    { bf16_t* Wcs = (bf16_t*)(wsl + WS_WCS); const float sc = 0.08838834764831845f;
      for (int i = gt; i < 256 * 128 / 8; i += NGT) { const int rw = i >> 4, c0 = (i & 15) * 8, l = rw & 127; float v[8];
#pragma unroll
          for (int e = 0; e < 8; ++e) { const int c = c0 + e; const int r = (l * c) & 127; const float x = (float)(2 * r) * (1.f / 128.f);
              v[e] = (rw < 128 ? cospif(x) : sinpif(x)) * sc; }
          *(u32x4*)(Wcs + (size_t)i * 8) = pack8(v); } }
    { bf16_t* SC = (bf16_t*)(wsl + WS_SC);
      for (int i = gt; i < 256 * 1024 / 8; i += NGT) { const int rw = i >> 7, c0 = (i & 127) * 8; float v[8];
#pragma unroll
          for (int e = 0; e < 8; ++e) { float x = 0.f; if (rw < 32) x = a.in[oidx(I_C)][rw * 1024 + c0 + e]; else if (rw == 32) x = a.in[oidx(I_CCTX)][c0 + e];
              v[e] = rw <= 32 ? x / (1.f + __expf(-x)) : 0.f; }
          *(u32x4*)(SC + (size_t)i * 8) = pack8(v); } }
}

__device__ __forceinline__ void norm_phase(const Args& a, unsigned char* wsl, float* outl, int layer, int which, int mrows, int wv) {
    const int tid = otid(wv), lane = tid & 63, wave = tid >> 6;
    const int gw = blockIdx.x * NWAVES + wave, NGW = gridDim.x * NWAVES;
    const bool first = (layer == 0 && which == 0);
    const float* g = a.in[which ? I_N2G : I_N1G] + layer * 1024;
    const float* MOD = (const float*)(wsl + WS_MOD) + (size_t)layer * NMODROW * 6144;
    bf16_t* X = (bf16_t*)(wsl + WS_X); bf16_t* H = (bf16_t*)(wsl + WS_H);
    const float* xin = a.in[oidx(I_X)]; const float* cin = a.in[oidx(I_CTX)];
    f32x4 nx[4];
    if (gw < mrows) { const float* src = gw < ML ? xin + (size_t)gw * DM : cin + (size_t)(gw - ML) * DM;
#pragma unroll
        for (int j = 0; j < 4; ++j) nx[j] = __builtin_nontemporal_load((const f32x4*)(src + lane * 4 + 256 * j)); }
    for (int m = gw; m < mrows; m += NGW) {
        const int brow = m < ML ? (m >> 11) : 32;
        const float* sh = MOD + (size_t)brow * 6144 + (which ? 3 : 0) * 1024; const float* scp = sh + 1024;
        f32x4 v[4]; float ss = 0.f;
#pragma unroll
        for (int j = 0; j < 4; ++j) { v[j] = nx[j]; ss += (v[j].x * v[j].x + v[j].y * v[j].y) + (v[j].z * v[j].z + v[j].w * v[j].w); }
        { const int mn = m + NGW; if (mn < mrows) { const float* src = mn < ML ? xin + (size_t)mn * DM : cin + (size_t)(mn - ML) * DM;
#pragma unroll
            for (int j = 0; j < 4; ++j) nx[j] = __builtin_nontemporal_load((const f32x4*)(src + lane * 4 + 256 * j)); } }
        if (first) {
#pragma unroll
            for (int j = 0; j < 4; ++j) *(unsigned long long*)(X + (size_t)m * DM + lane * 4 + 256 * j) = (unsigned long long)cvt_pk(v[j].x, v[j].y) | ((unsigned long long)cvt_pk(v[j].z, v[j].w) << 32);
        }
        const float rstd = rsqrtf(wave_sum(ss) * (1.f / DM) + EPS);
#pragma unroll
        for (int j = 0; j < 4; ++j) { const int c = lane * 4 + 256 * j;
            const f32x4 gg = *(const f32x4*)(g + c), s1 = *(const f32x4*)(scp + c), s0 = *(const f32x4*)(sh + c);
            const f32x4 h = (v[j] * rstd * gg) * (s1 + 1.f) + s0;
            unsigned long long o = (unsigned long long)cvt_pk(h.x, h.y) | ((unsigned long long)cvt_pk(h.z, h.w) << 32);
            *(unsigned long long*)(H + (size_t)m * DM + c) = o; }
    }
}
__device__ __forceinline__ void final_phase(const Args& a, unsigned char* wsl, float* outl, int wv) {
    const int tid = otid(wv), lane = tid & 63, wave = tid >> 6;
    const int gw = blockIdx.x * NWAVES + wave, NGW = gridDim.x * NWAVES;
    const float* g = a.in[oidx(I_FING)];
    const bf16_t* X = (const bf16_t*)(wsl + WS_X);
    unsigned long long nx[4] = {0ull, 0ull, 0ull, 0ull};
    if (gw < ML) {
#pragma unroll
        for (int j = 0; j < 4; ++j) nx[j] = __builtin_nontemporal_load((const unsigned long long*)(X + (size_t)gw * DM + lane * 4 + 256 * j)); }
    for (int m = gw; m < ML; m += NGW) {
        float* p = outl + (size_t)m * DM;
        f32x4 v[4]; float ss = 0.f;
#pragma unroll
        for (int j = 0; j < 4; ++j) { const unsigned long long w = nx[j];
            v[j] = (f32x4){bf_lo((unsigned)w), bf_hi((unsigned)w), bf_lo((unsigned)(w >> 32)), bf_hi((unsigned)(w >> 32))}; ss += (v[j].x * v[j].x + v[j].y * v[j].y) + (v[j].z * v[j].z + v[j].w * v[j].w); }
        if (m + NGW < ML) {
#pragma unroll
            for (int j = 0; j < 4; ++j) nx[j] = __builtin_nontemporal_load((const unsigned long long*)(X + (size_t)(m + NGW) * DM + lane * 4 + 256 * j)); }
        const float rstd = rsqrtf(wave_sum(ss) * (1.f / DM) + EPS);
#pragma unroll
        for (int j = 0; j < 4; ++j) { const int c = lane * 4 + 256 * j; const f32x4 gg = *(const f32x4*)(g + c); __builtin_nontemporal_store(v[j] * rstd * gg, (f32x4*)(p + c)); }
    }
}

__device__ __forceinline__ void q1_phase(const Args& a, unsigned char* wsl, float* outl, int j, int wv) {
    const int tid = otid(wv), lane = tid & 63, wave = tid >> 6;
    const int gw = blockIdx.x * NWAVES + wave, NGW = gridDim.x * NWAVES;
    const bf16_t* P = (const bf16_t*)(wsl + R_P);
    bf16_t* CQ = (bf16_t*)(wsl + R_CQ); bf16_t* QG = (bf16_t*)(wsl + R_QG); bf16_t* CKV = (bf16_t*)(wsl + R_CKV);
    bf16_t* KG = (bf16_t*)(wsl + R_KG); bf16_t* VG = (bf16_t*)(wsl + R_VG); bf16_t* KR = (bf16_t*)(wsl + R_KR);
    const float* gq = a.in[oidx(I_QNG)] + j * 512; const float* gkv = a.in[oidx(I_KVNG)] + j * 256;
    const float* ggq = a.in[oidx(I_GQNG)] + j * 128; const float* ggk = a.in[oidx(I_GKNG)] + j * 128;
    const int l16 = lane & 15;
    u32x4 nx0 = {0u, 0u, 0u, 0u}, nx1 = nx0, nx2 = nx0, nx3 = nx0;
    if (gw < MT) { const bf16_t* pr = P + (size_t)gw * 2048; nx0 = *(const u32x4*)(pr + lane * 8); nx1 = *(const u32x4*)(pr + 512 + lane * 8); nx2 = *(const u32x4*)(pr + 1024 + lane * 8); nx3 = *(const u32x4*)(pr + 1536 + lane * 8); }
    for (int m = gw; m < MT; m += NGW) {
        const bool lat = m < ML; const int t = m & 2047; const int prow = t >> 6, pcol = t & 63;
        const int kr = kvrow_of(m);
        float v[8];
        const u32x4 w0 = nx0, w1 = nx1, w2 = nx2, w3 = nx3;
        if (m + NGW < MT) { const bf16_t* pr = P + (size_t)(m + NGW) * 2048; nx0 = *(const u32x4*)(pr + lane * 8); nx1 = *(const u32x4*)(pr + 512 + lane * 8); nx2 = *(const u32x4*)(pr + 1024 + lane * 8); nx3 = *(const u32x4*)(pr + 1536 + lane * 8); }
        { unpack8(w0, v); float ss = 0.f;
#pragma unroll
          for (int e = 0; e < 8; ++e) ss += v[e] * v[e];
          const float rstd = rsqrtf(wave_sum(ss) * (1.f / 512.f) + EPS);
          const f32x4 g0 = *(const f32x4*)(gq + lane * 8), g1 = *(const f32x4*)(gq + lane * 8 + 4);
#pragma unroll
          for (int e = 0; e < 4; ++e) { v[e] = v[e] * rstd * g0[e]; v[4 + e] = v[4 + e] * rstd * g1[e]; }
          *(u32x4*)(CQ + (size_t)m * 512 + lane * 8) = pack8(v); }
        { unpack8(w1, v); float ss = 0.f;
#pragma unroll
          for (int e = 0; e < 8; ++e) ss += v[e] * v[e];
          ss += sx<1>(ss); ss += sx<2>(ss); ss += sx<4>(ss); ss += sx<8>(ss);
          const float rstd = rsqrtf(ss * (1.f / 128.f) + EPS);
          const f32x4 g0 = *(const f32x4*)(ggq + l16 * 8), g1 = *(const f32x4*)(ggq + l16 * 8 + 4);
#pragma unroll
          for (int e = 0; e < 4; ++e) { v[e] = v[e] * rstd * g0[e]; v[4 + e] = v[4 + e] * rstd * g1[e]; }
          rope8<4>(v, l16 >> 3, (l16 & 4) == 0, (l16 & 3) * 8, 1.f / 32.f, prow, pcol, lat);
          *(u32x4*)(QG + (size_t)m * 512 + lane * 8) = pack8(v); }
        { unpack8(w2, v); float ss = 0.f;
#pragma unroll
          for (int e = 0; e < 8; ++e) ss += v[e] * v[e];
          ss += sx<1>(ss); ss += sx<2>(ss); ss += sx<4>(ss); ss += sx<8>(ss);
          const float s32 = ss + sx<16>(ss);
          const bool lo = lane < 32;
          const float rstd = lo ? rsqrtf(s32 * (1.f / 256.f) + EPS) : rsqrtf(ss * (1.f / 128.f) + EPS);
          const float* gp = lo ? gkv + lane * 8 : ggk + l16 * 8;
          const f32x4 g0 = *(const f32x4*)gp, g1 = *(const f32x4*)(gp + 4);
#pragma unroll
          for (int e = 0; e < 4; ++e) { v[e] = v[e] * rstd * g0[e]; v[4 + e] = v[4 + e] * rstd * g1[e]; }
          rope8<4>(v, l16 >> 3, (l16 & 4) == 0, (l16 & 3) * 8, 1.f / 32.f, prow, pcol, lat && !lo);
          bf16_t* dst = lo ? CKV + (size_t)m * 256 + lane * 8 : KG + (size_t)kr * 256 + (lane - 32) * 8;
          *(u32x4*)dst = pack8(v); }
        { const u32x4 w = w3; unpack8(w, v);
          const int l8 = lane & 7;
          rope8<2>(v, l8 >> 2, (l8 & 2) == 0, (l8 & 1) * 8, 1.f / 16.f, prow, pcol, lat && lane >= 32 && lane < 40);
          if (lane < 32) *(u32x4*)(VG + (size_t)kr * 256 + lane * 8) = w;
          else if (lane < 40) *(u32x4*)(KR + (size_t)kr * 64 + (lane - 32) * 8) = pack8(v); }
    }
}

__device__ __forceinline__ void conv_phase(const Args& a, unsigned char* wsl, float* outl, int j, bool with_ctx, LAS unsigned char* lds, int wv) {
    const int tid = otid(wv), lane = tid & 63, wave = tid >> 6;
    const bf16_t* Ub = (const bf16_t*)(wsl + R_U); bf16_t* MIX = (bf16_t*)(wsl + WS_H);
    float w[31];
#pragma unroll
    for (int k = 0; k < 31; ++k) w[k] = a.in[oidx(I_CONVW)][((size_t)j * 31 + k) * 512 + tid];
    const float cb = a.in[oidx(I_CONVB)][j * 512 + tid];
    const float* lg = a.in[oidx(I_LNG)] + j * 512 + lane * 8; const float* lb = a.in[oidx(I_LNB)] + j * 512 + lane * 8;
    const f32x4 lg0 = *(const f32x4*)lg, lg1 = *(const f32x4*)(lg + 4), lb0 = *(const f32x4*)lb, lb1 = *(const f32x4*)(lb + 4);
    LAS bf16_t* U = (LAS bf16_t*)lds; LAS float* Y = (LAS float*)(lds + 65536);
    {
        const bf16_t* PF = (const bf16_t*)(wsl + R_P); const bf16_t* Wc = (const bf16_t*)(wsl + WS_WCS);
        const int nrow = 32 * 512 * (with_ctx ? 2 : 1);
        for (int idx = blockIdx.x * NTHREADS + tid; idx < nrow; idx += gridDim.x * NTHREADS) {
            const bool cx = idx >= 32 * 512; const int r = cx ? idx - 32 * 512 : idx, b = r >> 9, gl = r & 511, g = gl >> 7, l = gl & 127;
            const bf16_t* xr = PF + (size_t)(cx ? ML + b * 256 + 128 : b * 2048 + 1024) * 512 + g * 128; const bf16_t* wrow = Wc + l * 128;
            float acc = 0.f;
#pragma unroll
            for (int c8 = 0; c8 < 16; ++c8) { float xv[8], wv8[8]; unpack8(*(const u32x4*)(xr + c8 * 8), xv); unpack8(*(const u32x4*)(wrow + c8 * 8), wv8);
#pragma unroll
                for (int e = 0; e < 8; ++e) acc = fmaf(xv[e], wv8[e], acc); }
            bf16_t* dst = cx ? (bf16_t*)(wsl + R_YTFC) + (size_t)r * 256 + 128 : (bf16_t*)(wsl + R_YTF) + (size_t)r * 2048 + 1024;
            *dst = (bf16_t)(cvt_pk(acc, 0.f) & 0xffffu);
        }
    }
    const int nunits = 32 * 64 + (with_ctx ? 32 * 8 : 0);
    const int cvcu = (gridDim.x % 8 == 0) ? (blockIdx.x % 8) * (gridDim.x / 8) + blockIdx.x / 8 : blockIdx.x;
    for (int u = cvcu; u < nunits; u += gridDim.x) {
        int base, T, t0;
        if (u < 2048) { base = (u >> 6) * 2048; T = 2048; t0 = (u & 63) * 32; } else { const int uu = u - 2048; base = ML + (uu >> 3) * 256; T = 256; t0 = (uu & 7) * 32; }
        __syncthreads();
        {
            u32x4 ar[8];
#pragma unroll
            for (int q = 0; q < 8; ++q) { const int it = tid + q * NTHREADS, pi = it >> 6, c8 = (it & 63) * 8, p = t0 - 15 + pi;
                const bool ok = (it < 62 * 64) && p >= 0 && p < T;
                ar[q] = ok ? *(const u32x4*)(Ub + (size_t)(base + p) * 512 + c8) : (u32x4){0u, 0u, 0u, 0u}; }
#pragma unroll
            for (int q = 0; q < 8; ++q) { const int it = tid + q * NTHREADS, pi = it >> 6, c8 = (it & 63) * 8;
                if (it < 62 * 64) *(LAS u32x4*)(U + pi * 512 + c8) = ar[q]; }
        }
        __syncthreads();
#pragma unroll 1
        for (int tb = 0; tb < 4; ++tb) {
            float x[38];
#pragma unroll
            for (int i = 0; i < 38; ++i) x[i] = __uint_as_float((unsigned)U[(tb * 8 + i) * 512 + tid] << 16);
            float acc[8];
#pragma unroll
            for (int t = 0; t < 8; ++t) acc[t] = cb;
#pragma unroll
            for (int t = 0; t < 8; ++t)
#pragma unroll
                for (int k = 0; k < 31; ++k) acc[t] = fmaf(w[k], x[t + k], acc[t]);
#pragma unroll
            for (int t = 0; t < 8; ++t) Y[(tb * 8 + t) * 512 + tid] = acc[t];
        }
        __syncthreads();
        for (int t = wave; t < 32; t += NWAVES) {
            const f32x4 y0 = *(const LAS f32x4*)(Y + t * 512 + lane * 8), y1 = *(const LAS f32x4*)(Y + t * 512 + lane * 8 + 4);
            const float mean = wave_sum((y0.x + y0.y) + (y0.z + y0.w) + (y1.x + y1.y) + (y1.z + y1.w)) * (1.f / 512.f);
            const f32x4 d0 = y0 - mean, d1 = y1 - mean;
            const float var = wave_sum((d0.x * d0.x + d0.y * d0.y) + (d0.z * d0.z + d0.w * d0.w) + (d1.x * d1.x + d1.y * d1.y) + (d1.z * d1.z + d1.w * d1.w)) * (1.f / 512.f);
            const float rstd = rsqrtf(var + EPS);
            const f32x4 z0 = d0 * rstd * lg0 + lb0, z1 = d1 * rstd * lg1 + lb1;
            float o[8];
#pragma unroll
            for (int e = 0; e < 4; ++e) { o[e] = z0[e] / (1.f + __expf(-z0[e])); o[4 + e] = z1[e] / (1.f + __expf(-z1[e])); }
            *(u32x4*)(MIX + (size_t)(base + t0 + t) * 1024 + 512 + lane * 8) = pack8(o);
        }
    }
    __syncthreads();
}


__device__ __forceinline__ void fold_rows(const bf16_t* Yt, bf16_t* Yf, int N, int lgN, int gt, int NGT, int rev) {
    const int vpr = N >> 3, nvec = 32 * 512 * vpr, H = N >> 1;
    for (int ib = gt; ib < nvec; ib += 4 * NGT) {
        u32x4 wf[4], w0[4], w1[4]; unsigned wh[4];
#pragma unroll
        for (int q = 0; q < 4; ++q) { const int i0 = ib + q * NGT; const bool ok = i0 < nvec; const int i = ok ? (rev ? nvec - 1 - i0 : i0) : 0;
            const int rowi = i >> (lgN - 3), j0 = (i & (vpr - 1)) * 8;
            const bf16_t* yc = Yt + (size_t)rowi * 2 * N; const bool sinp = j0 >= H; const int t0 = sinp ? j0 - H : j0;
            const bf16_t* y = sinp ? yc + N : yc; const int a = N - t0 - 8;
            wf[q] = *(const u32x4*)(y + t0); w0[q] = *(const u32x4*)(y + a); w1[q] = *(const u32x4*)(y + (t0 > 0 ? a + 8 : a)); wh[q] = yc[H]; }
#pragma unroll
        for (int q = 0; q < 4; ++q) { const int i0 = ib + q * NGT; if (i0 < nvec) { const int i = rev ? nvec - 1 - i0 : i0;
            const int rowi = i >> (lgN - 3), j0 = (i & (vpr - 1)) * 8; const bool sinp = j0 >= H; const int t0 = sinp ? j0 - H : j0;
            float f[8], m0[8], m1[8], o[8]; unpack8(wf[q], f); unpack8(w0[q], m0); unpack8(w1[q], m1);
#pragma unroll
            for (int e = 0; e < 8; ++e) { const float p = (e == 0) ? (t0 > 0 ? m1[0] : 0.f) : m0[8 - e]; o[e] = sinp ? f[e] - p : f[e] + p; }
            if (t0 == 0) o[0] = sinp ? bf_lo(wh[q]) : f[0];
            *(u32x4*)(Yf + (size_t)rowi * N + j0) = pack8(o); } }
    }
}
__device__ __forceinline__ void fold_phase(unsigned char* wsl, bool with_ctx, int rev, int wv) {
    const int tid = otid(wv);
    const int gt = blockIdx.x * NTHREADS + tid, NGT = gridDim.x * NTHREADS;
    fold_rows((const bf16_t*)(wsl + R_YT), (bf16_t*)(wsl + R_YTF), 2048, 11, gt, NGT, rev);
    if (with_ctx) fold_rows((const bf16_t*)(wsl + R_YTC), (bf16_t*)(wsl + R_YTFC), 256, 8, gt, NGT, rev);
}

__device__ __forceinline__ void attn_phase(const Args& a, unsigned char* wsl, float* outl, bool with_ctx, char* lds, int wv) {
    const int G = gridDim.x, bx = blockIdx.x;
    const int vcu = (G % 8 == 0) ? (bx % 8) * (G / 8) + bx / 8 : bx;
    unsigned char* ws = wsl;
    const bf16_t* QM = (const bf16_t*)(ws + R_QM); const bf16_t* QR = (const bf16_t*)(ws + R_QR); const bf16_t* KM = (const bf16_t*)(ws + R_KM); const bf16_t* VM = (const bf16_t*)(ws + R_VM);
    const bf16_t* QG = (const bf16_t*)(ws + R_QG); const bf16_t* KG = (const bf16_t*)(ws + R_KG); const bf16_t* VG = (const bf16_t*)(ws + R_VG); const bf16_t* KR = (const bf16_t*)(ws + R_KR);
    bf16_t* O = (bf16_t*)(ws + WS_H);
    const int n_long = 2048, n_short = with_ctx ? 256 : 0;
    for (int idx = vcu; idx < n_long + n_short; idx += G) {
        int kind, b, h, qrow, seq;
        if (idx < n_long) { kind = idx >> 10; const int rem = idx & 1023; b = rem >> 5; h = (rem >> 3) & 3; qrow = b * SEQ + (rem & 7) * 256; seq = KVL; }
        else { const int i2 = idx - n_long; kind = i2 >> 7; b = (i2 >> 2) & 31; h = i2 & 3; qrow = ML + b * CTXL; seq = CTXL; }
        const size_t kv0 = (size_t)b * KVL;
        att::Job J;
        if (kind == 0) { J.Q = QM + (size_t)qrow * 512 + h * 128; J.ldq = 512; J.Q2 = QR + (size_t)qrow * 256 + h * 64; J.ldq2 = 256;
            J.K = KM + kv0 * 512 + h * 128; J.V = VM + kv0 * 512 + h * 128; J.ldk = 512; J.K2 = KR + kv0 * 64;
            J.O = O + (size_t)qrow * 1024 + h * 128; J.scale = 0.07216878364870322f; J.rope = 1; }
        else { J.Q = QG + (size_t)qrow * 512 + h * 128; J.ldq = 512; J.Q2 = J.Q; J.ldq2 = 512;
            J.K = KG + kv0 * 256 + (h >> 1) * 128; J.V = VG + kv0 * 256 + (h >> 1) * 128; J.ldk = 256; J.K2 = J.K;
            J.O = O + (size_t)qrow * 1024 + 512 + h * 128; J.scale = 0.08838834764831845f; J.rope = 0; }
        J.ldo = 1024; J.seq = seq;
        __syncthreads();
        if (kind == 0) att::attn_unit<true>(J, lds, wv); else att::attn_unit<false>(J, lds, wv);
    }
    __syncthreads();
}

enum { T_SETUP = 0, T_ADALN, T_PRE, T_G1, T_Q1, T_G2, T_AT, T_G3, T_G4, T_G5, T_CONV, T_D2, T_FINAL, T_FOLD };
struct Job { pg8::Gemm g; pg8::Sched s; pg8::Epi e; };
__device__ __forceinline__ void store_epi(pg8::Epi& e, int mode, bf16_t* C, int ldc) { e.mode = mode; e.C = C; e.C2 = C; e.ldc = ldc; e.rmask = 0x7fffffff; e.rshift = 31; e.rstep = 0; e.c_z = 0; }
__device__ __forceinline__ Job make_job(const Args& a, unsigned char* wsl, float* outl, LAS unsigned char* ldsl, int type, int layer, int jobi, int mtiles, int rev) {
    Job J; unsigned char* ws = wsl; const int j = layer >> 1; const bool attnl = (layer & 1) == 0;
    pg8::Sched& s = J.s; pg8::Epi& e = J.e;
    s.G = gridDim.x; s.c = blockIdx.x; s.zdiv = 1; s.a_z = 0; s.b_z1 = 0; s.b_z2 = 0;
    e.mode = 0; e.C = nullptr; e.C2 = nullptr; e.ldc = 0; e.rmask = 0x7fffffff; e.rshift = 31; e.rstep = 0; e.c_z = 0;
    e.X = (bf16_t*)(ws + WS_X); e.gate = nullptr; e.bias = nullptr; e.modout = nullptr; e.shiftout = nullptr;
    e.elds = ldsl; e.wsb = ws; e.gqn = nullptr; e.gkn = nullptr; e.ssqc = (float*)(ws + WS_SSQC); e.ssqk = (float*)(ws + WS_SSQK); e.ssq = nullptr; e.sw = nullptr; e.xg = nullptr; e.ng = nullptr; e.nsc = nullptr; e.ssq_out = (float*)(ws + WS_SSQ);
    const bf16_t* A = nullptr; const bf16_t* B = nullptr; int lda = 0, ldb = 0, K = 0, nMz = mtiles, nN = 0, Z = 1; size_t hstepB = 0, btile = 0;
    const float* MOD = (const float*)(ws + WS_MOD) + (size_t)layer * NMODROW * 6144;
    switch (type) {
        case T_ADALN: A = (const bf16_t*)(ws + WS_SC); lda = 1024; B = (const bf16_t*)(ws + R_MODWT); ldb = 1024; K = 1024; nMz = 1; nN = 96;
            e.mode = pg8::M_MOD; e.bias = a.in[oidx(I_MODB)]; e.modout = (float*)(ws + WS_MOD); e.shiftout = (bf16_t*)(ws + WS_SHIFT); break;
        case T_PRE: {
            const int l = jobi >> 1, w = jobi & 1, jj = l >> 1;
            A = (const bf16_t*)(ws + WS_SHIFT) + (size_t)jobi * 64 * 1024; lda = 1024; ldb = 1024; K = 1024; nMz = 1;
            if (w) { B = (const bf16_t*)(ws + WS_W1) + (size_t)l * 4096 * 1024; nN = 16; }
            else if ((l & 1) == 0) { B = (const bf16_t*)(ws + WS_WIN) + (size_t)jj * 2048 * 1024; nN = 8; }
            else { B = (const bf16_t*)(ws + WS_FCIN) + (size_t)jj * 1536 * 1024; nN = 6; }
            e.mode = pg8::M_SW; e.modout = (float*)(ws + WS_SW) + (size_t)jobi * NMODROW * 4096;
            s.c = (blockIdx.x + 32 * jobi) % gridDim.x; } break;
        case T_G1: A = (const bf16_t*)(ws + WS_H); lda = 1024; ldb = 1024; K = 1024;
            if (attnl) { B = (const bf16_t*)(ws + WS_WIN) + (size_t)j * 2048 * 1024; nN = 8; e.mode = pg8::M_QKV; e.gqn = a.in[oidx(I_GQNG)] + j * 128; e.gkn = a.in[oidx(I_GKNG)] + j * 128; }
            else { B = (const bf16_t*)(ws + WS_FCIN) + (size_t)j * 1536 * 1024; nN = 6; e.mode = pg8::M_FCIN; }
            if (layer > 0) { e.ssq = (const float*)(ws + WS_SSQ); e.sw = (const float*)(ws + WS_SW) + (size_t)(layer * 2) * NMODROW * 4096; }
            break;
        case T_G2:
            if (jobi == 0) { if (layer == 2) nMz = ML / 256;
                A = (const bf16_t*)(ws + R_CQ); lda = 512; B = (const bf16_t*)(ws + WS_UQ) + (size_t)j * 768 * 512; ldb = 512; K = 512; nN = 3;
                e.mode = pg8::M_UQ; e.C = (bf16_t*)(ws + R_QM); e.C2 = (bf16_t*)(ws + R_QR); }
            else { A = (const bf16_t*)(ws + R_CKV); lda = 256; B = (const bf16_t*)(ws + WS_UKV) + (size_t)j * 1024 * 256; ldb = 256; K = 256; nN = 4;
                e.mode = pg8::M_UKV; e.C = (bf16_t*)(ws + R_KM); e.C2 = (bf16_t*)(ws + R_VM); }
            break;
        case T_G3: A = (const bf16_t*)(ws + WS_H); lda = 1024; ldb = 1024; K = 1024; nN = 4;
            B = attnl ? (const bf16_t*)(ws + WS_AOUT) + (size_t)j * 1024 * 1024 : (const bf16_t*)(ws + WS_FCOUT) + (size_t)j * 1024 * 1024;
            e.mode = pg8::M_RESID; e.gate = MOD + 2 * 1024;
            e.xg = (bf16_t*)outl; e.ng = a.in[oidx(I_N2G)] + layer * 1024; e.nsc = MOD + 4 * 1024; break;
        case T_G4: A = (const bf16_t*)outl; lda = 1024; B = (const bf16_t*)(ws + WS_W1) + (size_t)layer * 4096 * 1024; ldb = 1024; K = 1024; nN = 16;
            store_epi(e, pg8::M_RELU2, (bf16_t*)(ws + R_HID), 4096);
            e.ssq = (const float*)(ws + WS_SSQ); e.sw = (const float*)(ws + WS_SW) + (size_t)(layer * 2 + 1) * NMODROW * 4096; break;
        case T_G5: A = (const bf16_t*)(ws + R_HID); lda = 4096; B = (const bf16_t*)(ws + WS_W2) + (size_t)layer * 1024 * 4096; ldb = 4096; K = 4096; nN = 4;
            e.mode = pg8::M_RESID; e.gate = MOD + 5 * 1024;
            if (layer < 3) { e.xg = (bf16_t*)(ws + WS_H); e.ng = a.in[oidx(I_N1G)] + (layer + 1) * 1024; e.nsc = MOD + (size_t)NMODROW * 6144 + 1 * 1024; } break;
        case T_CONV:
            A = (const bf16_t*)(ws + WS_WCS); lda = 128; K = 128; nMz = 1; ldb = 512; s.zdiv = 4; Z = 128; s.b_z2 = 128 * 2; hstepB = R_PFM - R_P; btile = (size_t)128 * 512 * 2;
            e.mode = pg8::M_D1F;
            if (jobi == 0) { B = (const bf16_t*)(ws + R_P); s.b_z1 = (size_t)2048 * 512 * 2; nN = 8; e.C = (bf16_t*)(ws + R_YTF); e.ldc = 2048; }
            else { B = (const bf16_t*)(ws + R_P) + (size_t)ML * 512; s.b_z1 = (size_t)256 * 512 * 2; nN = 1; e.C = (bf16_t*)(ws + R_YTFC); e.ldc = 256; }
            break;
        default:
            Z = 32; nN = 2;
            if (jobi == 0) { A = (const bf16_t*)(ws + WS_A2); lda = 2048; K = 2048; nMz = 8; B = (const bf16_t*)(ws + R_YTF); ldb = 2048; s.b_z1 = (size_t)512 * 2048 * 2;
                store_epi(e, pg8::M_STORE, (bf16_t*)(ws + WS_H), 1024); e.c_z = (size_t)2048 * 1024; }
            else { A = (const bf16_t*)(ws + WS_A2C); lda = 256; K = 256; nMz = 1; B = (const bf16_t*)(ws + R_YTFC); ldb = 256; s.b_z1 = (size_t)512 * 256 * 2;
                store_epi(e, pg8::M_STORE, (bf16_t*)(ws + WS_H) + (size_t)ML * 1024, 1024); e.c_z = (size_t)256 * 1024; }
            break;
    }
    J.g.lda = lda; J.g.ldb = ldb; J.g.K = K; J.g.hstepB = hstepB;
    s.A = (const char*)A; s.B = (const char*)B; s.nMz = nMz; s.nN = nN; s.nVP = Z * nMz; s.nwg = s.nVP * nN;
    s.a_tile = (size_t)256 * lda * 2; s.b_tile = btile ? btile : (size_t)256 * ldb * 2;
    s.nmine = s.c < s.nwg ? (s.nwg - 1 - s.c) / s.G + 1 : 0; s.rev = rev;
    return J;
}


#define XB_TMO      128
#define XB_XCNT(j)  (256  + 64 * (j))
#define XB_XSUB(j)  (1280 + 64 * (j))
#define XB_XGEN(j)  (2304 + 64 * (j))
#define XB_TOP      3328
#define XB_TOPGEN   3392
#define XCD_BAR_WORDS 3456
#define XB_SPIN_CAP (1u << 18)
__device__ __forceinline__ unsigned xb_ld(unsigned* p)              { return __hip_atomic_load(p, __ATOMIC_RELAXED, __HIP_MEMORY_SCOPE_AGENT); }
__device__ __forceinline__ unsigned xb_add(unsigned* p, unsigned v) { return __hip_atomic_fetch_add(p, v, __ATOMIC_RELAXED, __HIP_MEMORY_SCOPE_AGENT); }
__device__ __forceinline__ unsigned xb_xcc_id() { return (unsigned)__builtin_amdgcn_s_getreg((3 << 11) | 20) & 0xFu; }
#define XB_SPIN(cond, bar) do { unsigned _sp = 0; while (cond) { __builtin_amdgcn_s_sleep(1); \
    if ((++_sp & 255u) == 0u) { if (xb_ld(&(bar)[XB_TMO])) break; if (_sp > XB_SPIN_CAP) { atomicAdd(&(bar)[XB_TMO], 1u); break; } } } } while (0)
struct XcdBarrier { unsigned* bar; unsigned x; volatile LAS unsigned* st; };
__device__ __forceinline__ XcdBarrier xcd_barrier_post(unsigned* bar, volatile LAS unsigned* st) {
    XcdBarrier b; b.bar = bar; b.x = xb_xcc_id(); b.st = st;
    if (threadIdx.x == 0) (void)xb_add(&bar[XB_XCNT(b.x)], 1u);
    return b;
}
__device__ __forceinline__ void xcd_barrier_complete(unsigned* bar, unsigned x, unsigned& nloc, unsigned& nx) {
    const unsigned G = gridDim.x * gridDim.y * gridDim.z;
    unsigned sum, cnt, mine, sp = 0u;
    for (;;) {
        sum = 0u; cnt = 0u; mine = 0u;
#pragma unroll
        for (unsigned j = 0; j < 16; ++j) { const unsigned c = xb_ld(&bar[XB_XCNT(j)]); sum += c; cnt += (c > 0u) ? 1u : 0u; mine = (j == x) ? c : mine; }
        if (sum == G) break;
        __builtin_amdgcn_s_sleep(1);
        if ((++sp & 255u) == 0u) { if (xb_ld(&bar[XB_TMO])) break; if (sp > XB_SPIN_CAP) { atomicAdd(&bar[XB_TMO], 1u); break; } }
    }
    nloc = mine > 0u ? mine : 1u; nx = cnt > 0u ? cnt : 1u;
}
__device__ __forceinline__ void xcd_barrier(const XcdBarrier& b) {
    asm volatile("s_waitcnt vmcnt(0)" ::: "memory");
    __syncthreads();
    if (threadIdx.x == 0) {
        unsigned* bar = b.bar;
        __builtin_amdgcn_s_waitcnt(0);
        unsigned nloc = b.st[0], nx = b.st[1];
        if (nloc == 0u) { xcd_barrier_complete(bar, b.x, nloc, nx); b.st[0] = nloc; b.st[1] = nx; }
        const unsigned old = xb_add(&bar[XB_XSUB(b.x)], 1u);
        const unsigned gen = old / nloc;
        if (old + 1u == (gen + 1u) * nloc) {
            __builtin_amdgcn_fence(__ATOMIC_RELEASE, "agent");
            asm volatile("s_waitcnt vmcnt(0)" ::: "memory");
            const unsigned og = xb_add(&bar[XB_TOP], 1u);
            const unsigned tg = og / nx;
            if (og + 1u == (tg + 1u) * nx) xb_add(&bar[XB_TOPGEN], 1u);
            else XB_SPIN(xb_ld(&bar[XB_TOPGEN]) == tg, bar);
            __builtin_amdgcn_fence(__ATOMIC_ACQUIRE, "agent");
            xb_add(&bar[XB_XGEN(b.x)], 1u);
            asm volatile("s_waitcnt vmcnt(0)" ::: "memory");
        } else {
            XB_SPIN(xb_ld(&bar[XB_XGEN(b.x)]) == gen, bar);
            __builtin_amdgcn_fence(__ATOMIC_ACQUIRE, "agent");
            asm volatile("s_waitcnt vmcnt(0)" ::: "memory");
        }
    }
    __syncthreads();
}

#ifndef DUP_MASK
#define DUP_MASK 0ull
#endif
#ifndef SKIP_MASK
#define SKIP_MASK 0ull
#endif
__global__ void __launch_bounds__(NTHREADS, 2) fwd_megakernel(Args args) {
    extern __shared__ __attribute__((aligned(16))) unsigned char lds[];
    cg::grid_group grid = cg::this_grid();
    LAS unsigned char* ldsl = (LAS unsigned char*)lds;
    const int wv = __builtin_amdgcn_readfirstlane(threadIdx.x >> 6);
    volatile LAS unsigned* bst = (volatile LAS unsigned*)(ldsl + LDS_BYTES - 64);
    if (threadIdx.x < 2) bst[threadIdx.x] = 0u;
    __syncthreads();
    const XcdBarrier bar = xcd_barrier_post((unsigned*)(args.ws + WS_CTL), bst);
    if (args.ph_hi < 0) grid.sync();
    for (int ph = args.ph_lo; ph < args.ph_hi; ++ph) {
        unsigned char* wsl = args.ws; float* outl = args.out;
        asm volatile("" : "+s"(wsl)); asm volatile("" : "+s"(outl));
        int type, layer = 0;
        if (ph == 0) type = T_SETUP;
        else if (ph == 1) type = T_ADALN;
        else if (ph == 2) type = T_PRE;
        else if (ph >= 27) type = T_FINAL;
        else {
            int q = ph - 3, sub;
            layer = q / 6; sub = q - layer * 6;
            if ((layer & 1) == 0) { const int tt[6] = {T_G1, T_G2, T_AT, T_G3, T_G4, T_G5}; type = T_G1;
#pragma unroll
                for (int i = 0; i < 6; ++i) if (sub == i) type = tt[i]; }
            else { const int tt[6] = {T_G1, T_CONV, T_D2, T_G3, T_G4, T_G5}; type = T_G1;
#pragma unroll
                for (int i = 0; i < 6; ++i) if (sub == i) type = tt[i]; }
        }
        int mrows = MT;
        if (layer == 3) mrows = ML;
        if (layer == 2 && (type == T_G3 || type == T_G4 || type == T_G5)) mrows = ML;
        const bool ctx_full = layer < 2;
        const int nrep = ((DUP_MASK >> ph) & 1ull) ? 2 : 1;
        for (int rep = 0; rep < nrep; ++rep) {
        if (rep) grid.sync();
        int njobs = 0;
        if ((SKIP_MASK >> ph) & 1ull) type = -1;
        switch (type) {
            case T_SETUP: setup_phase(args, wsl, outl, ldsl, wv); break;
            case T_PRE: norm_phase(args, wsl, outl, 0, 0, MT, wv); njobs = 8; break;
            case T_AT: attn_phase(args, wsl, outl, layer == 0, (char*)lds, wv); break;
            case T_CONV: conv_phase(args, wsl, outl, layer >> 1, ctx_full, ldsl, wv); njobs = ctx_full ? 2 : 1; break;
            case T_FINAL: final_phase(args, wsl, outl, wv); break;
            case T_G2: njobs = 2; break;
            case T_D2: njobs = ctx_full ? 2 : 1; break;
            case -1: break;
            default: njobs = 1; break;
        }
        for (int jb = 0; jb < njobs; ++jb) {
            const Job J = make_job(args, wsl, outl, ldsl, type, layer, jb, mrows / 256, ph & 1);
            pg8::gemm_phase(ldsl, J.g, J.s, J.e, wv);
        }
        }
        if (ph + 1 < args.ph_hi) xcd_barrier(bar);
    }
#ifdef EXTRA_SYNCS
    for (int i = 0; i < EXTRA_SYNCS; ++i) grid.sync();
#endif
}

#ifndef N_PHASES_RUN
#define N_PHASES_RUN 28
#endif
constexpr int N_PHASES = N_PHASES_RUN;
#ifndef MK_PER_PHASE
#define MK_PER_PHASE 0
#endif
extern "C" void kernel_launch(void* const* d_in, const int* in_sizes, int n_in, void* d_out, int out_size, void* d_ws, size_t ws_size, hipStream_t stream) {
    static int grid = 0;
    if (grid == 0) {
        if (n_in != 25 || in_sizes[0] != ML * DM || out_size != ML * DM || ws_size < WS_END) {
            fprintf(stderr, "kernel_launch: unexpected shapes: n_in %d in0 %d out %d ws %zu (need %zu)\n", n_in, n_in > 0 ? in_sizes[0] : -1, out_size, ws_size, (size_t)WS_END); grid = -1; return; }
        int dev = 0, cus = 0, per_cu = 0;
        hipGetDevice(&dev); hipDeviceGetAttribute(&cus, hipDeviceAttributeMultiprocessorCount, dev);
        if (hipFuncSetAttribute((const void*)fwd_megakernel, hipFuncAttributeMaxDynamicSharedMemorySize, LDS_BYTES) != hipSuccess) { fprintf(stderr, "kernel_launch: hipFuncSetAttribute failed\n"); grid = -1; return; }
        if (hipOccupancyMaxActiveBlocksPerMultiprocessor(&per_cu, (const void*)fwd_megakernel, NTHREADS, LDS_BYTES) != hipSuccess || per_cu < 1) { fprintf(stderr, "kernel_launch: occupancy query gave %d\n", per_cu); per_cu = 1; }
        (void)hipGetLastError();
        grid = cus * per_cu;
    }
    if (grid < 0) return;
    Args a{};
    for (int i = 0; i < 25; ++i) a.in[i] = (const float*)d_in[i];
    a.out = (float*)d_out; a.ws = (unsigned char*)d_ws;
#if MK_PER_PHASE
    for (int ph = 0; ph < N_PHASES; ++ph) {
        a.ph_lo = ph; a.ph_hi = ph + 1;
        hipLaunchKernelGGL(fwd_megakernel, dim3(grid), dim3(NTHREADS), LDS_BYTES, stream, a);
    }
#else
    a.ph_lo = 0; a.ph_hi = N_PHASES;
    if (hipMemsetAsync((char*)d_ws + WS_CTL, 0, 16384, stream) != hipSuccess) { fprintf(stderr, "kernel_launch: memset of the barrier words failed\n"); return; }
    void* kargs[] = {&a};
    hipError_t e = hipLaunchCooperativeKernel((const void*)fwd_megakernel, dim3(grid), dim3(NTHREADS), kargs, LDS_BYTES, stream);
    if (e != hipSuccess) fprintf(stderr, "kernel_launch: cooperative launch failed: %s (grid %d)\n", hipGetErrorString(e), grid);
#endif
}
```

```cpp
#include <hip/hip_runtime.h>
#include <hip/hip_cooperative_groups.h>
#include <cstdio>
#include <cstdint>
namespace cg = cooperative_groups;

#define LAS __attribute__((address_space(3)))
typedef unsigned short bf16_t;
typedef short bf16x8 __attribute__((ext_vector_type(8)));
typedef short s16x4 __attribute__((ext_vector_type(4)));
typedef float f32x4 __attribute__((ext_vector_type(4)));
typedef float f32x16 __attribute__((ext_vector_type(16)));
typedef unsigned u32x4 __attribute__((ext_vector_type(4)));

constexpr int DM = 1024, NB = 32, SEQ = 2048, CTXL = 256, DFF = 4096;
constexpr int ML = NB * SEQ;
constexpr int MC = NB * CTXL;
constexpr int MT = ML + MC;
constexpr int KVL = SEQ + CTXL;
constexpr float EPS = 1e-6f;
constexpr int NMODROW = 33;
constexpr size_t MiB = 1u << 20;
constexpr size_t WS_MOD = 0;
constexpr size_t WS_CTL = 3 * MiB + 512 * 1024;
constexpr size_t WS_SC = 4 * MiB;
constexpr size_t WS_WCS = 5 * MiB;
constexpr size_t WS_A2C = 5 * MiB + 256 * 1024;
constexpr size_t WS_A2 = 8 * MiB;
constexpr size_t WS_WIN = 24 * MiB;
constexpr size_t WS_UQ = 32 * MiB;
constexpr size_t WS_UKV = 34 * MiB;
constexpr size_t WS_AOUT = 36 * MiB;
constexpr size_t WS_FCIN = 40 * MiB;
constexpr size_t WS_FCOUT = 46 * MiB;
constexpr size_t WS_W1 = 50 * MiB;
constexpr size_t WS_W2 = 82 * MiB;
constexpr size_t WS_CX = 120 * MiB;
constexpr size_t WS_H = 152 * MiB;
constexpr size_t WS_R = 296 * MiB;
constexpr size_t R_P = WS_R;
constexpr size_t R_PFM = WS_R + 144 * MiB;
constexpr size_t R_U = WS_R + 72 * MiB;
constexpr size_t R_QG = WS_R + 288 * MiB;
constexpr size_t R_KG = WS_R + 360 * MiB;
constexpr size_t R_VG = WS_R + 396 * MiB;
constexpr size_t R_CQ = WS_R + 432 * MiB;
constexpr size_t R_CKV = WS_R + 504 * MiB;
constexpr size_t R_KR = WS_R + 540 * MiB;
constexpr size_t R_QM = WS_R;
constexpr size_t R_QR = WS_R + 72 * MiB;
constexpr size_t R_KM = WS_R + 108 * MiB;
constexpr size_t R_VM = WS_R + 180 * MiB;
constexpr size_t R_YT = WS_R + 216 * MiB;
constexpr size_t R_YTC = WS_R + 344 * MiB;
constexpr size_t R_YTF = WS_R + 360 * MiB;
constexpr size_t R_YTFC = WS_R + 424 * MiB;
constexpr size_t R_HID = WS_R;
constexpr size_t R_MODWT = WS_R;
constexpr size_t WS_X = WS_R + 576 * MiB;
constexpr size_t WS_SSQ = 1016 * MiB;
constexpr size_t WS_SHIFT = 1020 * MiB + 512 * 1024;
constexpr size_t WS_SW = 114 * MiB;
constexpr size_t WS_SSQC = 118 * MiB + 512 * 1024;
constexpr size_t WS_SSQK = 119 * MiB + 256 * 1024;
constexpr size_t WS_END = 1022 * MiB;

constexpr int NTHREADS = 512, NWAVES = 8;
constexpr int RING_BYTES = 131072;
constexpr int LDS_BYTES = 163840;

__device__ __forceinline__ unsigned cvt_pk(float lo, float hi) { unsigned r; asm volatile("v_cvt_pk_bf16_f32 %0, %1, %2" : "=v"(r) : "v"(lo), "v"(hi)); return r; }
__device__ __forceinline__ float bf_lo(unsigned w) { return __uint_as_float(w << 16); }
__device__ __forceinline__ float bf_hi(unsigned w) { return __uint_as_float(w & 0xffff0000u); }
__device__ __forceinline__ void unpack8(u32x4 w, float (&v)[8]) {
    v[0] = bf_lo(w.x); v[1] = bf_hi(w.x); v[2] = bf_lo(w.y); v[3] = bf_hi(w.y); v[4] = bf_lo(w.z); v[5] = bf_hi(w.z); v[6] = bf_lo(w.w); v[7] = bf_hi(w.w); }
__device__ __forceinline__ u32x4 pack8(const float (&v)[8]) { u32x4 w; w.x = cvt_pk(v[0], v[1]); w.y = cvt_pk(v[2], v[3]); w.z = cvt_pk(v[4], v[5]); w.w = cvt_pk(v[6], v[7]); return w; }
template <int K> __device__ __forceinline__ float sx(float v) {
    static_assert(K >= 1 && K < 32, "sx: mask < 32");
    return __int_as_float(__builtin_amdgcn_ds_swizzle(__float_as_int(v), (K << 10) | 0x1F));
}
__device__ __forceinline__ float sum32x(float v) {
    auto rr = __builtin_amdgcn_permlane32_swap(__float_as_uint(v), __float_as_uint(v), false, false);
    return __uint_as_float(rr[0]) + __uint_as_float(rr[1]);
}
__device__ __forceinline__ float get32x(float v, bool lane_lt32) {
    auto rr = __builtin_amdgcn_permlane32_swap(__float_as_uint(v), __float_as_uint(v), false, false);
    return lane_lt32 ? __uint_as_float(rr[1]) : __uint_as_float(rr[0]);
}
__device__ __forceinline__ float wave_sum(float v) {
    v += sx<1>(v); v += sx<2>(v); v += sx<4>(v); v += sx<8>(v); v += sx<16>(v);
    return sum32x(v);
}
__device__ __forceinline__ int kvrow_of(int row) { return row < ML ? (row >> 11) * KVL + CTXL + (row & 2047) : ((row - ML) >> 8) * KVL + ((row - ML) & 255); }
#define LDS_WAIT() asm volatile("s_waitcnt lgkmcnt(0)" ::: "memory")
__device__ __forceinline__ int otid(int wv) { int l; asm volatile("v_mbcnt_lo_u32_b32 %0, -1, 0\n\tv_mbcnt_hi_u32_b32 %0, -1, %0" : "=v"(l)); return (wv << 6) | l; }

template <int XM> __device__ __forceinline__ void rope8(float (&v)[8], int sec, bool first, int i0, float inv_nf, int prow, int pcol, bool doit) {
    const float pos = (float)(sec ? pcol : prow);
#pragma unroll
    for (int e = 0; e < 8; ++e) {
        float pv; if constexpr (XM == 32) pv = get32x(v[e], first); else pv = sx<XM>(v[e]);
        const float fr = __builtin_amdgcn_exp2f(-(float)(i0 + e) * inv_nf * 13.287712379549449f);
        const float ang = pos * fr; const float c = __cosf(ang), s = __sinf(ang);
        const float r = first ? v[e] * c - pv * s : pv * s + v[e] * c;
        v[e] = doit ? r : v[e];
    }
}

__device__ __forceinline__ void rope_cs(float (&cs)[8], float (&sn)[8], int sec, int i0, float inv_nf, int prow, int pcol) {
    const float pos = (float)(sec ? pcol : prow);
#pragma unroll
    for (int e = 0; e < 8; ++e) { const float ang = pos * __builtin_amdgcn_exp2f(-(float)(i0 + e) * inv_nf * 13.287712379549449f); cs[e] = __cosf(ang); sn[e] = __sinf(ang); }
}
__device__ __forceinline__ void rope_apply32(float (&v)[8], const float (&cs)[8], const float (&sn)[8], bool first, bool doit) {
#pragma unroll
    for (int e = 0; e < 8; ++e) { const float pv = get32x(v[e], first); const float r = first ? v[e] * cs[e] - pv * sn[e] : pv * sn[e] + v[e] * cs[e]; v[e] = doit ? r : v[e]; }
}
namespace pg8 {
constexpr int BM = 256, BK = 64, HALF = 128, HTB = HALF * BK * 2, NXCD = 8, WGM = 8;
__device__ __forceinline__ int lds_byte(int r, int c) { const int st = (r >> 4) * 2 + (c >> 5), rr = r & 15, cc = c & 31, ob = rr * 64 + cc * 2; return st * 1024 + (ob ^ (((ob >> 9) & 1) << 5)); }
__device__ __forceinline__ void stage_rc(int b, int& R, int& C) { const int st = b / 1024, sb = b % 1024, swz = sb ^ (((sb >> 9) & 1) << 5); R = (st >> 1) * 16 + swz / 64; C = (st & 1) * 32 + (swz % 64) / 2; }
__device__ __forceinline__ int perm32(int rho) { const int n = rho >> 4, i = rho & 15; return 8 * (i >> 2) + 4 * n + (i & 3); }

struct Unit { const char* A; const char* B; int pm, pn, z, pmz, par; };

struct Sched {
    const char* A; const char* B;
    int nMz, nN, nVP, nwg, G, c, zdiv, nmine, rev;
    size_t a_tile, b_tile, a_z, b_z1, b_z2;
    __device__ __forceinline__ bool next(int i, Unit& u) const {
        if (i >= nmine) return false;
        const long L = (long)(rev ? nmine - 1 - i : i) * G + c;
        int wgid = (int)L; { const int q = nwg / NXCD, r = nwg % NXCD, xcd = wgid % NXCD, off = wgid / NXCD; wgid = (xcd < r ? xcd * (q + 1) : r * (q + 1) + (xcd - r) * q) + off; }
        const int nig = WGM * nN, gid = wgid / nig, fm = gid * WGM, gsz = (nVP - fm) < WGM ? (nVP - fm) : WGM;
        const int vp = fm + ((wgid % nig) % gsz), pn = (wgid % nig) / gsz;
        const int z = vp / nMz, pmz = vp - z * nMz;
        u.pm = vp; u.pn = pn; u.z = z; u.pmz = pmz;
        u.A = A + (size_t)z * a_z + (size_t)pmz * a_tile;
        u.B = B + (size_t)(z / zdiv) * b_z1 + (size_t)(z % zdiv) * b_z2 + (size_t)pn * b_tile;
        return true;
    }
};

enum { M_STORE = 0, M_RELU2 = 1, M_RESID = 2, M_MOD = 3, M_UQ = 4, M_UKV = 5, M_SW = 6, M_QKV = 7, M_FCIN = 8, M_D1F = 9 };
struct Epi {
    int mode;
    bf16_t* C; bf16_t* C2;
    int ldc, rmask, rshift, rstep; size_t c_z;
    bf16_t* X; const float* gate;
    const float* bias; float* modout; bf16_t* shiftout;
    const float* ssq; const float* sw;
    bf16_t* xg; const float* ng; const float* nsc; float* ssq_out; LAS unsigned char* elds;
    unsigned char* wsb; const float* gqn; const float* gkn; float* ssqc; float* ssqk;
    __device__ __forceinline__ void operator()(const f32x4 (&acc)[2][2][4][2], const Unit& u, int wr, int wc, int fr, int fq) const {
        const int colt = 32 * wc + 8 * fq;
        if (mode == M_RESID) {
            const int trow0 = u.pm * BM; const int brow = trow0 < ML ? (trow0 >> 11) : 32;
            bf16_t* xb = X + (size_t)trow0 * DM + u.pn * BM + colt;
            f32x4 gt[2][2], gn[2][2];
#pragma unroll
            for (int bj = 0; bj < 2; ++bj) {
                const int col = u.pn * BM + bj * HALF + colt;
                const float* gp = gate + (size_t)brow * 6144 + col;
                gt[bj][0] = *(const f32x4*)gp; gt[bj][1] = *(const f32x4*)(gp + 4);
                if (xg) { const float* sp = nsc + (size_t)brow * 6144 + col;
                    gn[bj][0] = *(const f32x4*)(ng + col) * (*(const f32x4*)sp + 1.f); gn[bj][1] = *(const f32x4*)(ng + col + 4) * (*(const f32x4*)(sp + 4) + 1.f); }
                else { gn[bj][0] = (f32x4){0.f, 0.f, 0.f, 0.f}; gn[bj][1] = gn[bj][0]; }
            }
            u32x4 xv[3][2];
#define RS_ROWOFF(i) ((size_t)(((i) >> 2) * HALF + wr * 64 + ((i) & 3) * 16 + fr) * DM)
#define RS_LOAD(i, slot) do { const bf16_t* p_ = xb + RS_ROWOFF(i); xv[slot][0] = *(const u32x4*)p_; xv[slot][1] = *(const u32x4*)(p_ + HALF); } while (0)
            RS_LOAD(0, 0); RS_LOAD(1, 1);
#pragma unroll
            for (int i = 0; i < 8; ++i) {
                const int slot = i % 3, ai = i >> 2, m = i & 3;
                if (i + 2 < 8) RS_LOAD(i + 2, (i + 2) % 3);
                bf16_t* p = xb + RS_ROWOFF(i);
                float ssq_acc = 0.f;
#pragma unroll
                for (int bj = 0; bj < 2; ++bj) {
                    const u32x4 xw = xv[slot][bj];
                    const f32x4 xo0 = (f32x4){bf_lo(xw.x), bf_hi(xw.x), bf_lo(xw.y), bf_hi(xw.y)}, xo1 = (f32x4){bf_lo(xw.z), bf_hi(xw.z), bf_lo(xw.w), bf_hi(xw.w)};
                    const f32x4 x0 = xo0 + gt[bj][0] * acc[ai][bj][m][0], x1 = xo1 + gt[bj][1] * acc[ai][bj][m][1];
                    u32x4 xs; xs.x = cvt_pk(x0.x, x0.y); xs.y = cvt_pk(x0.z, x0.w); xs.z = cvt_pk(x1.x, x1.y); xs.w = cvt_pk(x1.z, x1.w);
                    *(u32x4*)(p + bj * HALF) = xs;
                    if (xg) {
                        ssq_acc += (x0.x * x0.x + x0.y * x0.y) + (x0.z * x0.z + x0.w * x0.w) + (x1.x * x1.x + x1.y * x1.y) + (x1.z * x1.z + x1.w * x1.w);
                        const f32x4 y0 = x0 * gn[bj][0], y1 = x1 * gn[bj][1];
                        u32x4 w; w.x = cvt_pk(y0.x, y0.y); w.y = cvt_pk(y0.z, y0.w); w.z = cvt_pk(y1.x, y1.y); w.w = cvt_pk(y1.z, y1.w);
                        const int row = trow0 + ai * HALF + wr * 64 + m * 16 + fr;
                        *(u32x4*)(xg + (size_t)row * DM + u.pn * BM + bj * HALF + colt) = w;
                    }
                }
                if (xg) { ssq_acc += sx<16>(ssq_acc); ssq_acc = sum32x(ssq_acc);
                    if (fq == 0) ((LAS float*)(elds + RING_BYTES))[wc * 256 + ai * HALF + wr * 64 + m * 16 + fr] = ssq_acc; }
            }
            if (xg) {
                LDS_WAIT(); __builtin_amdgcn_s_barrier();
                const int t = (wr * 4 + wc) * 64 + fq * 16 + fr;
                if (t < 256) { const LAS float* pp = (const LAS float*)(elds + RING_BYTES) + t; ssq_out[(size_t)(trow0 + t) * 4 + u.pn] = (pp[0] + pp[256]) + (pp[512] + pp[768]); }
            }
#undef RS_LOAD
#undef RS_ROWOFF
        } else if (mode == M_MOD || mode == M_SW) {
            if (wr == 0) {
#pragma unroll
                for (int m = 0; m < 3; ++m) {
                    const int row = m * 16 + fr;
                    if (row < NMODROW) {
#pragma unroll
                        for (int bj = 0; bj < 2; ++bj) {
                            const int cgl = u.pn * BM + bj * HALF + colt;
                            if (mode == M_SW) { float* o = modout + (size_t)row * 4096 + cgl; *(f32x4*)o = acc[0][bj][m][0]; *(f32x4*)(o + 4) = acc[0][bj][m][1]; }
                            else {
                                const int l = cgl / 6144, cc = cgl - l * 6144;
                                float* o = modout + ((size_t)(l * NMODROW + row)) * 6144 + cc;
                                const f32x4 b0 = *(const f32x4*)(bias + cgl), b1 = *(const f32x4*)(bias + cgl + 4);
                                const f32x4 v0 = acc[0][bj][m][0] + b0, v1 = acc[0][bj][m][1] + b1;
                                *(f32x4*)o = v0; *(f32x4*)(o + 4) = v1;
                                const int chunk = cc >> 10;
                                if (chunk == 0 || chunk == 3) {
                                    u32x4 w; w.x = cvt_pk(v0.x, v0.y); w.y = cvt_pk(v0.z, v0.w); w.z = cvt_pk(v1.x, v1.y); w.w = cvt_pk(v1.z, v1.w);
                                    *(u32x4*)(shiftout + ((size_t)((l * 2 + (chunk == 3 ? 1 : 0)) * 64 + row)) * 1024 + (cc & 1023)) = w;
                                }
                            }
                        }
                    }
                }
            }
        } else {
            float rstdv[8]; f32x4 swv[2][2];
            if (ssq) {
                const LAS unsigned char* pb = elds + RING_BYTES + 4096 + u.par * 5120;
#pragma unroll
                for (int bj = 0; bj < 2; ++bj) { swv[bj][0] = *(const LAS f32x4*)(pb + 4096 + (bj * HALF + colt) * 4); swv[bj][1] = *(const LAS f32x4*)(pb + 4096 + (bj * HALF + colt + 4) * 4); }
#pragma unroll
                for (int i = 0; i < 8; ++i) { const f32x4 q = *(const LAS f32x4*)(pb + ((i >> 2) * HALF + wr * 64 + (i & 3) * 16 + fr) * 16);
                    rstdv[i] = rsqrtf(((q.x + q.y) + (q.z + q.w)) * (1.f / DM) + EPS); }
            } else {
#pragma unroll
                for (int i = 0; i < 8; ++i) rstdv[i] = 1.f;
#pragma unroll
                for (int bj = 0; bj < 2; ++bj) { swv[bj][0] = (f32x4){0.f, 0.f, 0.f, 0.f}; swv[bj][1] = swv[bj][0]; }
            }
#define EP_V(I, BJ) float v[8]; { _Pragma("unroll") for (int e = 0; e < 4; ++e) { v[e] = acc[(I) >> 2][BJ][(I) & 3][0][e]; v[4 + e] = acc[(I) >> 2][BJ][(I) & 3][1][e]; } \
            if (ssq) { _Pragma("unroll") for (int e = 0; e < 4; ++e) { v[e] = fmaf(v[e], rstdv[I], swv[BJ][0][e]); v[4 + e] = fmaf(v[4 + e], rstdv[I], swv[BJ][1][e]); } } }
            if (mode == M_D1F) {
                const int N = ldc, Hh = N >> 1, t0 = u.pn * HALF + colt;
#pragma unroll
                for (int i = 0; i < 8; ++i) { const int rt = (i >> 2) * HALF + wr * 64 + (i & 3) * 16 + fr; const int cs = rt >> 7, l = rt & 127;
                    float o[8];
                    { EP_V(i, 0);
#pragma unroll
                        for (int e = 0; e < 8; ++e) o[e] = v[e]; }
                    { EP_V(i, 1);
#pragma unroll
                        for (int e = 0; e < 8; ++e) { const bool solo = (t0 == 0 && e == 0); o[e] = cs ? o[e] - v[e] : (solo ? o[e] : o[e] + v[e]); } }
                    bf16_t* dst = C + ((size_t)u.z * 128 + l) * N + (cs ? Hh : 0) + t0;
                    const u32x4 w = pack8(o);
                    if (cs && t0 == 0) {
                        unsigned short* d16 = (unsigned short*)dst; d16[1] = (unsigned short)(w.x >> 16); *(unsigned*)(d16 + 2) = w.y; *(unsigned*)(d16 + 4) = w.z; *(unsigned*)(d16 + 6) = w.w;
                    } else *(u32x4*)dst = w;
                }
            } else if (mode == M_FCIN) {
                const int pn = u.pn, trow0 = u.pm * BM;
                bf16_t* PF = (bf16_t*)(wsb + R_P); bf16_t* U = (bf16_t*)(wsb + R_U);
#pragma unroll
                for (int i = 0; i < 8; ++i) { const int row = trow0 + (i >> 2) * HALF + wr * 64 + (i & 3) * 16 + fr;
                    if (pn < 2) {
#pragma unroll
                        for (int bj = 0; bj < 2; ++bj) { EP_V(i, bj); const u32x4 w = pack8(v);
                            const int mrow = row < ML ? (row & ~2047) + ((2048 - (row & 2047)) & 2047) : ML + ((row - ML) & ~255) + ((256 - ((row - ML) & 255)) & 255);
                            *(u32x4*)(PF + (size_t)row * 512 + pn * BM + bj * HALF + colt) = w;
                            *(u32x4*)((bf16_t*)(wsb + R_PFM) + (size_t)mrow * 512 + pn * BM + bj * HALF + colt) = w; }
                    } else {
                        float av[8]; { EP_V(i, 0);
#pragma unroll
                            for (int e = 0; e < 8; ++e) av[e] = v[e]; }
                        { EP_V(i, 1);
#pragma unroll
                            for (int e = 0; e < 8; ++e) av[e] = av[e] / (1.f + __expf(-v[e])); }
                        *(u32x4*)(U + (size_t)row * 512 + (pn - 2) * HALF + colt) = pack8(av);
                    }
                }
            } else if (mode == M_QKV) {
                const int pn = u.pn, trow0 = u.pm * BM;
                bf16_t* CQ = (bf16_t*)(wsb + R_CQ); bf16_t* QG = (bf16_t*)(wsb + R_QG); bf16_t* CKV = (bf16_t*)(wsb + R_CKV);
                bf16_t* KG = (bf16_t*)(wsb + R_KG); bf16_t* VG = (bf16_t*)(wsb + R_VG); bf16_t* KR = (bf16_t*)(wsb + R_KR);
                if (pn == 2 || pn == 3 || pn == 5) {
                    LAS float* part2 = (LAS float*)(elds + RING_BYTES + 16384);
#pragma unroll
                    for (int i = 0; i < 8; ++i)
#pragma unroll
                        for (int bj = 0; bj < 2; ++bj) { EP_V(i, bj); float ss = 0.f;
#pragma unroll
                            for (int e = 0; e < 8; ++e) ss += v[e] * v[e];
                            ss += sx<16>(ss); ss = sum32x(ss);
                            if (fq == 0) part2[(bj * 4 + wc) * 256 + (i >> 2) * HALF + wr * 64 + (i & 3) * 16 + fr] = ss; }
                    LDS_WAIT(); __builtin_amdgcn_s_barrier();
                    const float* gh = (pn == 5 ? gkn : gqn) + 64 * (wc >> 1) + 32 * (fq >> 1) + 16 * (wc & 1) + 8 * (fq & 1);
                    const f32x4 g0 = *(const f32x4*)gh, g1 = *(const f32x4*)(gh + 4);
#pragma unroll
                    for (int i = 0; i < 8; ++i) { const int rt = (i >> 2) * HALF + wr * 64 + (i & 3) * 16 + fr, row = trow0 + rt;
                        const bool lat = row < ML; const int t = row & 2047;
                        bf16_t* dst = (pn == 5) ? KG + (size_t)kvrow_of(row) * 256 + colt : QG + (size_t)row * 512 + (pn - 2) * BM + colt;
                        float cs[8], sn[8]; rope_cs(cs, sn, wc >> 1, 16 * (wc & 1) + 8 * (fq & 1), 1.f / 32.f, t >> 6, t & 63);
#pragma unroll
                        for (int bj = 0; bj < 2; ++bj) { EP_V(i, bj);
                            const LAS float* pp = part2 + bj * 1024 + rt;
                            const float rh = rsqrtf(((pp[0] + pp[256]) + (pp[512] + pp[768])) * (1.f / 128.f) + EPS);
#pragma unroll
                            for (int e = 0; e < 4; ++e) { v[e] = v[e] * rh * g0[e]; v[4 + e] = v[4 + e] * rh * g1[e]; }
                            rope_apply32(v, cs, sn, fq < 2, lat);
                            *(u32x4*)(dst + bj * HALF) = pack8(v); } }
                } else if (pn == 7) {
#pragma unroll
                    for (int i = 0; i < 8; ++i) { const int row = trow0 + (i >> 2) * HALF + wr * 64 + (i & 3) * 16 + fr; const int t = row & 2047;
                        EP_V(i, 0);
                        rope8<32>(v, wc & 1, fq < 2, 8 * (fq & 1), 1.f / 16.f, t >> 6, t & 63, row < ML);
                        if (wc < 2) *(u32x4*)(KR + (size_t)kvrow_of(row) * 64 + colt) = pack8(v); }
                } else {
                    LAS float* part = (LAS float*)(elds + RING_BYTES);
#pragma unroll
                    for (int i = 0; i < 8; ++i) { const int rt = (i >> 2) * HALF + wr * 64 + (i & 3) * 16 + fr, row = trow0 + rt;
                        bf16_t* dst = pn < 2 ? CQ + (size_t)row * 512 + pn * BM + colt : (pn == 4 ? CKV + (size_t)row * 256 + colt : VG + (size_t)kvrow_of(row) * 256 + colt);
                        float ss = 0.f;
#pragma unroll
                        for (int bj = 0; bj < 2; ++bj) { EP_V(i, bj);
#pragma unroll
                            for (int e = 0; e < 8; ++e) ss += v[e] * v[e];
                            *(u32x4*)(dst + bj * HALF) = pack8(v); }
                        ss += sx<16>(ss); ss = sum32x(ss);
                        if (fq == 0) part[wc * 256 + rt] = ss; }
                    LDS_WAIT(); __builtin_amdgcn_s_barrier();
                    const int t = (wr * 4 + wc) * 64 + fq * 16 + fr;
                    if (t < 256 && pn != 6) { const LAS float* pp = part + t; const float sv = (pp[0] + pp[256]) + (pp[512] + pp[768]);
                        if (pn < 2) ssqc[(size_t)(trow0 + t) * 2 + pn] = sv; else ssqk[trow0 + t] = sv; }
                }
            } else {
            float r2v[8];
            if (mode == M_UQ) {
#pragma unroll
                for (int i = 0; i < 8; ++i) { const float* q = ssqc + (size_t)(u.pm * BM + (i >> 2) * HALF + wr * 64 + (i & 3) * 16 + fr) * 2; r2v[i] = q[0] + q[1]; }
#pragma unroll
                for (int i = 0; i < 8; ++i) r2v[i] = rsqrtf(r2v[i] * (1.f / 512.f) + EPS);
            } else if (mode == M_UKV) {
#pragma unroll
                for (int i = 0; i < 8; ++i) r2v[i] = ssqk[u.pm * BM + (i >> 2) * HALF + wr * 64 + (i & 3) * 16 + fr];
#pragma unroll
                for (int i = 0; i < 8; ++i) r2v[i] = rsqrtf(r2v[i] * (1.f / 256.f) + EPS);
            } else {
#pragma unroll
                for (int i = 0; i < 8; ++i) r2v[i] = 1.f;
            }
#pragma unroll
            for (int ai = 0; ai < 2; ++ai)
#pragma unroll
                for (int m = 0; m < 4; ++m) {
                    const int rt = ai * HALF + wr * 64 + m * 16 + fr;
                    const int row = u.pm * BM + rt;
                    bf16_t* dst; bool dorope = false; int prow = 0, pcol = 0;
                    if (mode == M_UQ) {
                        if (u.pn < 2) dst = C + (size_t)row * 512 + u.pn * BM;
                        else { dst = C2 + (size_t)row * 256; dorope = row < ML; const int t = row & 2047; prow = t >> 6; pcol = t & 63; }
                    } else if (mode == M_UKV) {
                        const int kr = kvrow_of(row);
                        dst = (u.pn < 2 ? C + u.pn * BM : C2 + (u.pn - 2) * BM) + (size_t)kr * 512;
                    } else {
                        const int rowv = u.pmz * BM + rt;
                        dst = C + (size_t)u.z * c_z + (size_t)(rowv & rmask) * ldc + (size_t)(rowv >> rshift) * rstep + u.pn * BM;
                    }
                    const float rstd = rstdv[ai * 4 + m];
                    float cs[8], sn[8];
                    if (mode == M_UQ && u.pn >= 2) rope_cs(cs, sn, wc & 1, (fq & 1) * 8, 1.f / 16.f, prow, pcol);
#pragma unroll
                    for (int bj = 0; bj < 2; ++bj) {
                        float v[8];
#pragma unroll
                        for (int e = 0; e < 4; ++e) { v[e] = acc[ai][bj][m][0][e]; v[4 + e] = acc[ai][bj][m][1][e]; }
                        if (ssq) {
#pragma unroll
                            for (int e = 0; e < 4; ++e) { v[e] = fmaf(v[e], rstd, swv[bj][0][e]); v[4 + e] = fmaf(v[4 + e], rstd, swv[bj][1][e]); }
                        }
                        if (mode == M_RELU2) {
#pragma unroll
                            for (int e = 0; e < 8; ++e) { const float r = fmaxf(v[e], 0.f); v[e] = r * r; }
                        }
                        if (mode == M_UQ || mode == M_UKV) { const float r2 = r2v[ai * 4 + m];
#pragma unroll
                            for (int e = 0; e < 8; ++e) v[e] *= r2; }
                        if (mode == M_UQ && u.pn >= 2) rope_apply32(v, cs, sn, fq < 2, dorope);
                        *(u32x4*)(dst + bj * HALF + colt) = pack8(v);
                    }
                }
            }
#undef EP_V
        }
    }
};

struct Gemm { int lda, ldb, K; size_t hstepB; };

#ifndef PG8_SP2
#define PG8_SP2 true
#endif
#ifndef PG8_ALIGN
#define PG8_ALIGN true
#endif
__device__ __forceinline__ void gemm_phase(LAS unsigned char* lds, const Gemm g, const Sched& S, const Epi& E, int wv) {
    constexpr bool SP2 = PG8_SP2, ALIGN_EPI = PG8_ALIGN;
    const int tid = otid(wv), wid = __builtin_amdgcn_readfirstlane(tid >> 6), lane = tid & 63, wr = wid >> 2, wc = wid & 3, fr = lane & 15, fq = lane >> 4;
    const int K = g.K, nt = K / BK;
    unsigned voffA[2], voffB[2];
#pragma unroll
    for (int i = 0; i < 2; ++i) { int R, C; stage_rc(tid * 16 + i * 8192, R, C); const int Rb = (R & ~31) + perm32(R & 31);
        voffA[i] = (unsigned)(R * g.lda + C) * 2u; voffB[i] = (unsigned)(Rb * g.ldb + C) * 2u; }
    const size_t kstep = (size_t)(BK * 2);
    const size_t hstepA = (size_t)HALF * g.lda * 2, hstepB = g.hstepB ? g.hstepB : (size_t)HALF * g.ldb * 2;
    const unsigned ldsw = (unsigned)wid * 1024u;
    const int aoff = lds_byte(wr * 64 + fr, fq * 8), boff = lds_byte(wc * 32 + fr, fq * 8);
#define PG8_SA(b, h) (((b) * 2 + (h)) * HTB)
#define PG8_SB(b, h) ((4 + (b) * 2 + (h)) * HTB)
#define PG8_STAGE(bufoff, gbase, voff) do { _Pragma("unroll") for (int _i = 0; _i < 2; ++_i) \
        __builtin_amdgcn_global_load_lds((const unsigned*)((const char*)(gbase) + (voff)[_i]), (LAS unsigned*)(lds + (bufoff) + ldsw + _i * 8192), 16, 0, 0); } while (0)
#define PG8_LDA(dst, b, h) do { _Pragma("unroll") for (int m = 0; m < 4; ++m) _Pragma("unroll") for (int k = 0; k < 2; ++k) dst[m][k] = *(const LAS bf16x8*)(lds + PG8_SA(b, h) + aoff + m * 2048 + k * 1024); } while (0)
#define PG8_LDB(dst, b, h) do { _Pragma("unroll") for (int n = 0; n < 2; ++n) _Pragma("unroll") for (int k = 0; k < 2; ++k) dst[n][k] = *(const LAS bf16x8*)(lds + PG8_SB(b, h) + boff + n * 2048 + k * 1024); } while (0)
#define PG8_MMA(ai, bj, At, Bt) do { __builtin_amdgcn_s_setprio(1); _Pragma("unroll") for (int m = 0; m < 4; ++m) _Pragma("unroll") for (int n = 0; n < 2; ++n) _Pragma("unroll") for (int k = 0; k < 2; ++k) \
        acc[ai][bj][m][n] = __builtin_amdgcn_mfma_f32_16x16x32_bf16(Bt[n][k], At[m][k], acc[ai][bj][m][n], 0, 0, 0); __builtin_amdgcn_s_setprio(0); } while (0)
#define PG8_PREF(U, PAR) do { if (E.ssq) { const int tr0_ = (U).pm * BM; \
        if (wid < 4) __builtin_amdgcn_global_load_lds((const unsigned*)(E.ssq + (size_t)tr0_ * 4 + (wid * 64 + lane) * 4), (LAS unsigned*)(lds + RING_BYTES + 4096 + (PAR) * 5120 + wid * 1024), 16, 0, 0); \
        else if (wid == 4) __builtin_amdgcn_global_load_lds((const unsigned*)(E.sw + (size_t)(tr0_ < ML ? (tr0_ >> 11) : 32) * 4096 + (U).pn * BM + lane * 4), (LAS unsigned*)(lds + RING_BYTES + 4096 + (PAR) * 5120 + 4096), 16, 0, 0); } } while (0)
#define PG8_WAIT_V(n) asm volatile("s_waitcnt vmcnt(" #n ")" ::: "memory")
#define PG8_WAIT_V_RX(f) asm volatile("s_cmp_eq_u32 %0, 0\n\ts_cbranch_scc1 1f\n\ts_waitcnt vmcnt(24)\n\ts_branch 2f\n1:\n\ts_waitcnt vmcnt(8)\n2:" :: "s"(f) : "scc", "memory")
#define PG8_WAIT_L(n) asm volatile("s_waitcnt lgkmcnt(" #n ")" ::: "memory")
#define PG8_BAR __builtin_amdgcn_s_barrier()
#define PG8_SCHED __builtin_amdgcn_sched_barrier(0)
    Unit cur, nxt; int ui = 0;
    if (!S.next(0, cur)) return;
    const bool relax = (E.mode != M_MOD && E.mode != M_SW && E.mode != M_QKV && E.mode != M_FCIN && E.mode != M_D1F);
    f32x4 acc[2][2][4][2];
#pragma unroll
    for (int a = 0; a < 2; ++a)
#pragma unroll
        for (int b = 0; b < 2; ++b)
#pragma unroll
            for (int m = 0; m < 4; ++m)
#pragma unroll
                for (int n = 0; n < 2; ++n) acc[a][b][m][n] = (f32x4){0.f, 0.f, 0.f, 0.f};
    bf16x8 At[4][2], B0[2][2], B1[2][2];
    const char* cA = cur.A; const char* cB = cur.B;
    cur.par = 0; PG8_PREF(cur, 0);
    if constexpr (SP2) {
        PG8_STAGE(PG8_SB(0, 0), cB, voffB); PG8_STAGE(PG8_SB(0, 1), cB + hstepB, voffB); PG8_STAGE(PG8_SA(0, 0), cA, voffA); PG8_STAGE(PG8_SA(0, 1), cA + hstepA, voffA);
        if (wr == 1) PG8_BAR;
        PG8_WAIT_V(2); PG8_BAR;
        PG8_STAGE(PG8_SB(1, 0), cB + kstep, voffB); PG8_STAGE(PG8_SA(1, 0), cA + kstep, voffA); PG8_STAGE(PG8_SB(1, 1), cB + hstepB + kstep, voffB);
        PG8_WAIT_V(6); PG8_BAR;
    } else {
    PG8_STAGE(PG8_SB(0, 0), cB, voffB); PG8_STAGE(PG8_SA(0, 0), cA, voffA); PG8_STAGE(PG8_SB(0, 1), cB + hstepB, voffB); PG8_STAGE(PG8_SA(0, 1), cA + hstepA, voffA);
    if (wr == 1) PG8_BAR;
    PG8_WAIT_V(4); PG8_BAR;
    PG8_STAGE(PG8_SB(1, 0), cB + kstep, voffB); PG8_STAGE(PG8_SA(1, 0), cA + kstep, voffA); PG8_STAGE(PG8_SB(1, 1), cB + hstepB + kstep, voffB);
    PG8_WAIT_V(6); PG8_BAR;
    }
    for (;;) {
        const bool has_next = S.next(ui + 1, nxt);
        const char* nA = has_next ? nxt.A : cA; const char* nB = has_next ? nxt.B : cB;
        for (int t = 0; t < nt; t += 2) {
            const bool last = (t == nt - 2);
            const char* a1 = cA + (size_t)(t + 1) * kstep;
            const char* a2 = last ? nA : cA + (size_t)(t + 2) * kstep; const char* b2 = last ? nB : cB + (size_t)(t + 2) * kstep;
            const char* a3 = a2 + kstep; const char* b3 = b2 + kstep;
            if constexpr (SP2) {
            const int rx = __builtin_amdgcn_readfirstlane((relax && ui > 0 && t == 0) ? 1 : 0);
            PG8_LDB(B0, 0, 0); PG8_LDB(B1, 0, 1); PG8_SCHED; PG8_LDA(At, 0, 0); PG8_STAGE(PG8_SA(1, 1), a1 + hstepA, voffA);
            PG8_WAIT_V_RX(rx);
            PG8_WAIT_L(0); PG8_BAR; PG8_MMA(0, 0, At, B0); PG8_MMA(0, 1, At, B1); PG8_BAR; PG8_SCHED;
            PG8_LDA(At, 0, 1); PG8_STAGE(PG8_SB(0, 0), b2, voffB); PG8_STAGE(PG8_SB(0, 1), b2 + hstepB, voffB); PG8_STAGE(PG8_SA(0, 0), a2, voffA);
            PG8_WAIT_V_RX(rx);
            PG8_WAIT_L(0); PG8_BAR; PG8_MMA(1, 0, At, B0); PG8_MMA(1, 1, At, B1); PG8_BAR; PG8_SCHED;
            PG8_LDB(B0, 1, 0); PG8_LDB(B1, 1, 1); PG8_SCHED; PG8_LDA(At, 1, 0); PG8_STAGE(PG8_SA(0, 1), a2 + hstepA, voffA);
            PG8_WAIT_V(8); PG8_WAIT_L(0); PG8_BAR; PG8_MMA(0, 0, At, B0); PG8_MMA(0, 1, At, B1); PG8_BAR; PG8_SCHED;
            PG8_LDA(At, 1, 1); PG8_STAGE(PG8_SB(1, 0), b3, voffB); PG8_STAGE(PG8_SB(1, 1), b3 + hstepB, voffB); PG8_STAGE(PG8_SA(1, 0), a3, voffA);
            PG8_WAIT_V(8); PG8_WAIT_L(0); PG8_BAR; PG8_MMA(1, 0, At, B0); PG8_MMA(1, 1, At, B1); PG8_BAR; PG8_SCHED;
            } else {
            PG8_LDB(B0, 0, 0); PG8_SCHED; PG8_LDA(At, 0, 0); PG8_STAGE(PG8_SA(1, 1), a1 + hstepA, voffA);
            PG8_WAIT_L(8); PG8_BAR; PG8_WAIT_L(0); PG8_MMA(0, 0, At, B0); PG8_BAR; PG8_SCHED;
            PG8_LDB(B1, 0, 1); PG8_STAGE(PG8_SB(0, 0), b2, voffB);
            PG8_BAR; PG8_WAIT_L(0); PG8_MMA(0, 1, At, B1); PG8_BAR;
            PG8_LDA(At, 0, 1); PG8_STAGE(PG8_SA(0, 0), a2, voffA);
            PG8_BAR; PG8_WAIT_L(0); PG8_MMA(1, 0, At, B0); PG8_BAR; PG8_SCHED;
            PG8_STAGE(PG8_SB(0, 1), b2 + hstepB, voffB);
            PG8_WAIT_V(6); PG8_BAR; PG8_MMA(1, 1, At, B1); PG8_BAR;
            PG8_LDB(B0, 1, 0); PG8_SCHED; PG8_LDA(At, 1, 0); PG8_STAGE(PG8_SA(0, 1), a2 + hstepA, voffA);
            PG8_WAIT_L(8); PG8_BAR; PG8_WAIT_L(0); PG8_MMA(0, 0, At, B0); PG8_BAR; PG8_SCHED;
            PG8_LDB(B1, 1, 1); PG8_STAGE(PG8_SB(1, 0), b3, voffB);
            PG8_BAR; PG8_WAIT_L(0); PG8_MMA(0, 1, At, B1); PG8_BAR;
            PG8_LDA(At, 1, 1); PG8_STAGE(PG8_SA(1, 0), a3, voffA);
            PG8_BAR; PG8_WAIT_L(0); PG8_MMA(1, 0, At, B0); PG8_BAR; PG8_SCHED;
            PG8_STAGE(PG8_SB(1, 1), b3 + hstepB, voffB);
            PG8_WAIT_V(6); PG8_BAR; PG8_MMA(1, 1, At, B1); PG8_BAR;
            }
        }
        if constexpr (ALIGN_EPI) { if (wr == 0) PG8_BAR; }
        { const int l2 = otid(wv) & 63; E(acc, cur, wr, wc, l2 & 15, l2 >> 4); }
        if (!has_next) break;
#pragma unroll
        for (int a = 0; a < 2; ++a)
#pragma unroll
            for (int b = 0; b < 2; ++b)
#pragma unroll
                for (int m = 0; m < 4; ++m)
#pragma unroll
                    for (int n = 0; n < 2; ++n) acc[a][b][m][n] = (f32x4){0.f, 0.f, 0.f, 0.f};
        cur = nxt; cA = nA; cB = nB; ++ui;
        cur.par = ui & 1; PG8_PREF(cur, ui & 1);
        if constexpr (ALIGN_EPI) { if (wr == 1) PG8_BAR; }
    }
    PG8_WAIT_V(0);
    if constexpr (!ALIGN_EPI) { if (wr == 0) PG8_BAR; }
    PG8_BAR;
#undef PG8_SA
#undef PG8_SB
#undef PG8_STAGE
#undef PG8_LDA
#undef PG8_LDB
#undef PG8_MMA
#undef PG8_WAIT_V
#undef PG8_PREF
#undef PG8_WAIT_V_RX
#undef PG8_WAIT_L
#undef PG8_BAR
#undef PG8_SCHED
}
}

namespace att {
constexpr int QBLK = 32, KVBLK = 64;
constexpr int SHM_V = 16384, SHM_K = 16384, SHM_K2 = 8192;
constexpr int OFF_V = 0, OFF_K = 32768, OFF_K2 = 65536, OFF_WS = 81920, OFF_Q2 = 86016;
#define KSWZ(row, colB) ((row) * 256 + ((colB) ^ (((row) & 7) << 4)))
#define K2SWZ(row, colB) ((row) * 128 + ((colB) ^ ((((row) >> 1) & 7) << 4)))
#define SBAR() __builtin_amdgcn_sched_barrier(0)
__device__ __forceinline__ int crow(int r, int hi) { return (r & 3) + 8 * (r >> 2) + 4 * hi; }

struct Job { const bf16_t* Q; const bf16_t* Q2; const bf16_t* K; const bf16_t* K2; const bf16_t* V; bf16_t* O; int ldq, ldq2, ldk, ldo, seq; float scale; int rope; };

__device__ __forceinline__ void partialSM(f32x16& p0, f32x16& p1, float& m_reg, float& mn, float& alpha, float C, float thr) {
    float pmax = p0[0];
#pragma unroll
    for (int r = 1; r < 16; ++r) pmax = fmaxf(pmax, p0[r]);
#pragma unroll
    for (int r = 0; r < 16; ++r) pmax = fmaxf(pmax, p1[r]);
    { auto rr = __builtin_amdgcn_permlane32_swap(__float_as_uint(pmax), __float_as_uint(pmax), false, false);
      pmax = fmaxf(__uint_as_float(rr[0]), __uint_as_float(rr[1])); }
    if (__builtin_expect(__all(pmax - m_reg <= thr), 1)) { mn = m_reg; alpha = 1.f; }
    else { mn = fmaxf(m_reg, pmax); alpha = __builtin_amdgcn_exp2f((m_reg - mn) * C); m_reg = mn; }
    const float mnC = -mn * C;
#pragma unroll
    for (int r = 0; r < 16; ++r) p0[r] = fmaf(p0[r], C, mnC);
#pragma unroll
    for (int r = 0; r < 16; ++r) p1[r] = fmaf(p1[r], C, mnC);
#pragma unroll
    for (int r = 0; r < 16; ++r) p0[r] = __builtin_amdgcn_exp2f(p0[r]);
}
__device__ __forceinline__ void finishSM(f32x16& p0, f32x16& p1, float alpha, float& l_reg, bf16x8& pa0, bf16x8& pa1, bf16x8& pa2, bf16x8& pa3) {
#pragma unroll
    for (int r = 0; r < 16; ++r) p1[r] = __builtin_amdgcn_exp2f(p1[r]);
    float ps = 0;
#pragma unroll
    for (int r = 0; r < 16; ++r) ps += p0[r];
#pragma unroll
    for (int r = 0; r < 16; ++r) ps += p1[r];
    { auto rr = __builtin_amdgcn_permlane32_swap(__float_as_uint(ps), __float_as_uint(ps), false, false);
      ps = __uint_as_float(rr[0]) + __uint_as_float(rr[1]); }
    l_reg = l_reg * alpha + ps;
#define PK4(P, BASE, OUT) do { unsigned a0 = cvt_pk(P[BASE + 0], P[BASE + 1]), a1 = cvt_pk(P[BASE + 2], P[BASE + 3]);   \
    unsigned b0 = cvt_pk(P[BASE + 4], P[BASE + 5]), b1 = cvt_pk(P[BASE + 6], P[BASE + 7]);                              \
    auto r0 = __builtin_amdgcn_permlane32_swap(a0, b0, false, false); auto r1 = __builtin_amdgcn_permlane32_swap(a1, b1, false, false); \
    u32x4 w = {r0[0], r1[0], r0[1], r1[1]}; OUT = *reinterpret_cast<bf16x8*>(&w); } while (0)
    PK4(p0, 0, pa0); PK4(p0, 8, pa1); PK4(p1, 0, pa2); PK4(p1, 8, pa3);
#undef PK4
}
template <bool ROPE> __device__ __forceinline__ void qkt(f32x16& p0, f32x16& p1, const char* Ks, const char* K2s, const bf16x8* qr, const char* q2s, int r32, int hi) {
    p0 = f32x16{}; p1 = f32x16{};
#pragma unroll
    for (int d0 = 0; d0 < 8; ++d0) { const int cb = (d0 * 16 + hi * 8) * 2;
        const bf16x8 b0 = *reinterpret_cast<const bf16x8*>(Ks + KSWZ(r32, cb));
        const bf16x8 b1 = *reinterpret_cast<const bf16x8*>(Ks + KSWZ(32 + r32, cb));
        bf16x8 q; if (!ROPE || d0 < 4) q = qr[d0]; else q = *reinterpret_cast<const bf16x8*>(q2s + d0 * 1024);
        p0 = __builtin_amdgcn_mfma_f32_32x32x16_bf16(b0, q, p0, 0, 0, 0);
        p1 = __builtin_amdgcn_mfma_f32_32x32x16_bf16(b1, q, p1, 0, 0, 0); }
    if (ROPE) {
#pragma unroll
        for (int d0 = 0; d0 < 4; ++d0) { const int cb = (d0 * 16 + hi * 8) * 2;
            const bf16x8 b0 = *reinterpret_cast<const bf16x8*>(K2s + K2SWZ(r32, cb));
            const bf16x8 b1 = *reinterpret_cast<const bf16x8*>(K2s + K2SWZ(32 + r32, cb));
            const bf16x8 q2 = *reinterpret_cast<const bf16x8*>(q2s + d0 * 1024);
            p0 = __builtin_amdgcn_mfma_f32_32x32x16_bf16(b0, q2, p0, 0, 0, 0);
            p1 = __builtin_amdgcn_mfma_f32_32x32x16_bf16(b1, q2, p1, 0, 0, 0); }
    }
}
__device__ __forceinline__ int v_st(int k, int c) { const int kk = (k & ~0xC) | ((k & 4) << 1) | ((k & 8) >> 1); return ((kk >> 3) * 4 + (c >> 5)) * 512 + ((kk & 7) * 32 + (c & 31)) * 2; }
__device__ __forceinline__ int v_rd_base(int lane) { return ((lane & 3) << 3) | (((lane >> 2) & 3) << 6) | (((lane >> 4) & 1) << 5) | (((lane >> 5) & 1) << 8); }
constexpr int v_rd_off(int d0, int ks, int half) { return d0 * 512 + ks * 4096 + half * 2048; }
template <int OFF> __device__ __forceinline__ s16x4 tr_read(int vb) {
    s16x4 r; asm volatile("ds_read_b64_tr_b16 %0, %1 offset:%2" : "=&v"(r) : "v"(vb), "i"(OFF) : "memory"); return r;
}
template <int D0> __device__ __forceinline__ void pv_one(f32x16& od, int vb, bf16x8 pa0, bf16x8 pa1, bf16x8 pa2, bf16x8 pa3) {
    const s16x4 l0 = tr_read<v_rd_off(D0, 0, 0)>(vb), h0 = tr_read<v_rd_off(D0, 0, 1)>(vb), l1 = tr_read<v_rd_off(D0, 1, 0)>(vb), h1 = tr_read<v_rd_off(D0, 1, 1)>(vb);
    const s16x4 l2 = tr_read<v_rd_off(D0, 2, 0)>(vb), h2 = tr_read<v_rd_off(D0, 2, 1)>(vb), l3 = tr_read<v_rd_off(D0, 3, 0)>(vb), h3 = tr_read<v_rd_off(D0, 3, 1)>(vb);
    asm volatile("s_waitcnt lgkmcnt(0)" ::: "memory"); SBAR();
#define PK(L, H) (bf16x8){L[0], L[1], L[2], L[3], H[0], H[1], H[2], H[3]}
    od = __builtin_amdgcn_mfma_f32_32x32x16_bf16(pa0, PK(l0, h0), od, 0, 0, 0);
    od = __builtin_amdgcn_mfma_f32_32x32x16_bf16(pa1, PK(l1, h1), od, 0, 0, 0);
    od = __builtin_amdgcn_mfma_f32_32x32x16_bf16(pa2, PK(l2, h2), od, 0, 0, 0);
    od = __builtin_amdgcn_mfma_f32_32x32x16_bf16(pa3, PK(l3, h3), od, 0, 0, 0);
#undef PK
}
__device__ __forceinline__ void pv_d0(f32x16* o, int vb, bf16x8 pa0, bf16x8 pa1, bf16x8 pa2, bf16x8 pa3) {
    pv_one<0>(o[0], vb, pa0, pa1, pa2, pa3); pv_one<1>(o[1], vb, pa0, pa1, pa2, pa3); pv_one<2>(o[2], vb, pa0, pa1, pa2, pa3); pv_one<3>(o[3], vb, pa0, pa1, pa2, pa3);
}

template <bool ROPE> __device__ __forceinline__ void attn_unit(const Job& J, char* lds, int wv) {
    const int tid = otid(wv), wid = tid >> 6, lane = tid & 63, r32 = lane & 31, hi = lane >> 5;
    char* V_lds = lds + OFF_V; char* K_lds = lds + OFF_K; char* K2_lds = lds + OFF_K2;
    float* ws = (float*)(lds + OFF_WS) + wid * 64; float* li_l = ws; float* al_l = ws + 32;
    const float C = J.scale * 1.4426950408889634f, thr = 8.f / J.scale;
    constexpr int rope = ROPE ? 1 : 0;
    float m_reg = -1e30f, l_reg = 0; f32x16 o[4] = {}; bf16x8 qr[ROPE ? 4 : 8];
    char* q2s = lds + OFF_Q2 + wid * 8192 + lane * 16;
    const bf16_t* Qw = J.Q + (long)(wid * QBLK + r32) * J.ldq + hi * 8;
#pragma unroll
    for (int d0 = 0; d0 < 4; ++d0) qr[d0] = *reinterpret_cast<const bf16x8*>(Qw + d0 * 16);
#pragma unroll
    for (int d0 = 4; d0 < 8; ++d0) { if constexpr (ROPE) *reinterpret_cast<bf16x8*>(q2s + d0 * 1024) = *reinterpret_cast<const bf16x8*>(Qw + d0 * 16); else qr[d0] = *reinterpret_cast<const bf16x8*>(Qw + d0 * 16); }
    if (rope) {
        const bf16_t* Q2w = J.Q2 + (long)(wid * QBLK + r32) * J.ldq2 + hi * 8;
#pragma unroll
        for (int d0 = 0; d0 < 4; ++d0) *reinterpret_cast<bf16x8*>(q2s + d0 * 1024) = *reinterpret_cast<const bf16x8*>(Q2w + d0 * 16);
    }
    const int sr = tid >> 4, sc = (tid & 15) * 8, vst0 = v_st(sr, sc), vst1 = v_st(32 + sr, sc);
    const int s2r = tid >> 3, s2c = (tid & 7) * 8;
    const int vb0 = (int)(uintptr_t)V_lds + v_rd_base(lane);
    const bf16_t* Kh = J.K; const bf16_t* Vh = J.V; const bf16_t* K2h = J.K2; const int LDK = J.ldk;
    bf16x8 vs0, vs1, ks0, ks1, k2s;
#define SLOAD(k0) do { vs0 = *reinterpret_cast<const bf16x8*>(&Vh[(long)((k0) + sr) * LDK + sc]); vs1 = *reinterpret_cast<const bf16x8*>(&Vh[(long)((k0) + 32 + sr) * LDK + sc]); \
    ks0 = *reinterpret_cast<const bf16x8*>(&Kh[(long)((k0) + sr) * LDK + sc]); ks1 = *reinterpret_cast<const bf16x8*>(&Kh[(long)((k0) + 32 + sr) * LDK + sc]); \
    if (rope) k2s = *reinterpret_cast<const bf16x8*>(&K2h[(long)((k0) + s2r) * 64 + s2c]); } while (0)
#define SWRITE(b) do { *(bf16x8*)(V_lds + (b) * SHM_V + vst0) = vs0; *(bf16x8*)(V_lds + (b) * SHM_V + vst1) = vs1; const int kc = sc * 2; \
    *(bf16x8*)(K_lds + (b) * SHM_K + KSWZ(sr, kc)) = ks0; *(bf16x8*)(K_lds + (b) * SHM_K + KSWZ(32 + sr, kc)) = ks1; \
    if (rope) *(bf16x8*)(K2_lds + (b) * SHM_K2 + K2SWZ(s2r, s2c * 2)) = k2s; } while (0)
#define SWAIT() asm volatile("s_waitcnt vmcnt(0)" ::: "memory")
#define RESC(a) do { if (__any((a) < 1.f)) { if (hi == 0) al_l[r32] = (a); asm volatile("s_waitcnt lgkmcnt(0)" ::: "memory"); \
    _Pragma("unroll") for (int d = 0; d < 4; ++d) _Pragma("unroll") for (int r = 0; r < 16; ++r) o[d][r] *= al_l[crow(r, hi)]; } } while (0)
    f32x16 pA0, pA1, pB0, pB1; float mnA, mnB, alA, alB; bf16x8 pa0, pa1, pa2, pa3; const int NT = J.seq / KVBLK;
    SLOAD(0); SWAIT(); SWRITE(0); __syncthreads();
    qkt<ROPE>(pA0, pA1, K_lds, K2_lds, qr, q2s, r32, hi); partialSM(pA0, pA1, m_reg, mnA, alA, C, thr);
    SLOAD(KVBLK);
    SWAIT(); SWRITE(1); __syncthreads();
    for (int j = 1; j + 1 < NT; j += 2) {
        SBAR(); qkt<ROPE>(pB0, pB1, K_lds + SHM_K, K2_lds + SHM_K2, qr, q2s, r32, hi);
        finishSM(pA0, pA1, alA, l_reg, pa0, pa1, pa2, pa3); SBAR();
        SLOAD((j + 1) * KVBLK); SBAR();
        pv_d0(o, vb0, pa0, pa1, pa2, pa3); partialSM(pB0, pB1, m_reg, mnB, alB, C, thr);
        __syncthreads(); SWAIT(); SWRITE(0);
        RESC(alB); __syncthreads();
        SBAR(); qkt<ROPE>(pA0, pA1, K_lds, K2_lds, qr, q2s, r32, hi);
        finishSM(pB0, pB1, alB, l_reg, pa0, pa1, pa2, pa3); SBAR();
        SLOAD((j + 2) * KVBLK); SBAR();
        pv_d0(o, vb0 + SHM_V, pa0, pa1, pa2, pa3); partialSM(pA0, pA1, m_reg, mnA, alA, C, thr);
        __syncthreads(); SWAIT(); SWRITE(1);
        RESC(alA); __syncthreads();
    }
    SBAR(); qkt<ROPE>(pB0, pB1, K_lds + SHM_K, K2_lds + SHM_K2, qr, q2s, r32, hi);
    finishSM(pA0, pA1, alA, l_reg, pa0, pa1, pa2, pa3); SBAR();
    pv_d0(o, vb0, pa0, pa1, pa2, pa3); partialSM(pB0, pB1, m_reg, mnB, alB, C, thr);
    __syncthreads(); RESC(alB);
    finishSM(pB0, pB1, alB, l_reg, pa0, pa1, pa2, pa3); SBAR();
    pv_d0(o, vb0 + SHM_V, pa0, pa1, pa2, pa3);
    if (hi == 0) li_l[r32] = l_reg; asm volatile("s_waitcnt lgkmcnt(0)" ::: "memory");
    float rli[16];
#pragma unroll
    for (int r = 0; r < 16; ++r) rli[r] = __builtin_amdgcn_rcpf(li_l[crow(r, hi)]);
    bf16_t* Ow = J.O + (long)(wid * QBLK) * J.ldo;
    char* ost = lds + OFF_Q2 + wid * 8192;
#pragma unroll
    for (int r = 0; r < 16; ++r) { const int orow = crow(r, hi);
#pragma unroll
        for (int d0 = 0; d0 < 4; ++d0) *(bf16_t*)(ost + orow * 256 + (d0 * 32 + r32) * 2) = (bf16_t)(cvt_pk(o[d0][r] * rli[r], 0.f) & 0xffffu); }
    asm volatile("s_waitcnt lgkmcnt(0)" ::: "memory");
#pragma unroll
    for (int k = 0; k < 8; ++k) { const int p = lane + 64 * k, row = p >> 4, c16 = p & 15;
        *(u32x4*)(Ow + (long)row * J.ldo + c16 * 8) = *(const u32x4*)(ost + row * 256 + c16 * 16); }
#undef SLOAD
#undef SWRITE
#undef SWAIT
#undef RESC
}
}

struct Args { const float* in[25]; float* out; unsigned char* ws; int ph_lo, ph_hi; };
__device__ __forceinline__ int oidx(int i) { asm volatile("" : "+s"(i)); return i; }
enum { I_X = 0, I_C, I_CTX, I_CCTX, I_MODW, I_MODB, I_N1G, I_N2G, I_AWIN, I_QNG, I_WUQ, I_KVNG, I_WUKV, I_GQNG, I_GKNG, I_AWOUT, I_FCWIN, I_CONVW, I_CONVB, I_LNG, I_LNB, I_FCWOUT, I_W1, I_W2, I_FING };

__device__ __forceinline__ int src_col(int kind, int n) {
    if (kind == 1) {
        if ((n >= 512 && n < 1024) || (n >= 1280 && n < 1536)) { const int b0 = n < 1024 ? 512 : 1280, sb = n < 1024 ? 512 : 1344, h = (n - b0) >> 7, c = (n - b0) & 127;
            const int wc = c >> 5, fq = (c >> 3) & 3, e = c & 7; return sb + h * 128 + 64 * (wc >> 1) + 32 * (fq >> 1) + 16 * (wc & 1) + 8 * (fq & 1) + e; }
        if (n < 1280) return n; if (n < 1792) return n + 64; if (n < 1856) return n - 512; return -1; }
    if (kind == 4) { if (n < 512) return n; const int c = n - 512, j = c >> 8, r = c & 255; return r < 128 ? 512 + 128 * j + r : 1024 + 128 * j + (r - 128); }
    if (kind == 2) { if (n < 512) return (n >> 7) * 192 + (n & 127); const int c = n - 512; return (c >> 6) * 192 + 128 + (c & 63); }
    if (kind == 3) { if (n < 512) return (n >> 7) * 256 + (n & 127); const int c = n - 512; return (c >> 7) * 256 + 128 + (c & 127); }
    return n;
}
__device__ __forceinline__ void transpose_item(const float* W, int K, int Nsrc, int Ndst, bf16_t* WT, int kind, const float* rscale, LAS float* scr, int item, int lane) {
    const int nblk = Ndst / 64, kb = item / nblk, nb = item - kb * nblk, k0 = 64 * kb, n0 = 64 * nb;
    const int kr = lane >> 4, n4 = (lane & 15) * 4;
    const int s0 = src_col(kind, n0 + n4);
    f32x4 v[16];
#pragma unroll
    for (int i = 0; i < 16; ++i) v[i] = s0 >= 0 ? __builtin_nontemporal_load((const f32x4*)(W + (size_t)(k0 + 4 * i + kr) * Nsrc + s0)) : (f32x4){0.f, 0.f, 0.f, 0.f};
    if (rscale) {
#pragma unroll
        for (int i = 0; i < 16; ++i) v[i] = v[i] * rscale[k0 + 4 * i + kr]; }
#pragma unroll
    for (int i = 0; i < 16; ++i) { LAS float* d = scr + (4 * i + kr) * 65 + n4; d[0] = v[i].x; d[1] = v[i].y; d[2] = v[i].z; d[3] = v[i].w; }
    LDS_WAIT(); asm volatile("" ::: "memory");
    const int c = lane & 7, nn = lane >> 3;
#pragma unroll
    for (int j = 0; j < 8; ++j) { const int n = nn + 8 * j; const LAS float* sp = scr + (8 * c) * 65 + n;
        u32x4 o; o.x = cvt_pk(sp[0 * 65], sp[1 * 65]); o.y = cvt_pk(sp[2 * 65], sp[3 * 65]); o.z = cvt_pk(sp[4 * 65], sp[5 * 65]); o.w = cvt_pk(sp[6 * 65], sp[7 * 65]);
        *(u32x4*)(WT + (size_t)(n0 + n) * K + k0 + 8 * c) = o; }
    LDS_WAIT(); asm volatile("" ::: "memory");
}
struct WDesc { const float* W; bf16_t* WT; const float* rscale; int K, Nsrc, Ndst, kind; };
__device__ __forceinline__ WDesc wdesc(const Args& a, unsigned char* wsl, float* outl, int d) {
    WDesc w; unsigned char* ws = wsl; w.rscale = nullptr;
    if (d < 4) { w.W = a.in[oidx(I_MODW)] + (size_t)d * 1024 * 6144; w.WT = (bf16_t*)(ws + R_MODWT) + (size_t)d * 6144 * 1024; w.K = 1024; w.Nsrc = 6144; w.Ndst = 6144; w.kind = 0; return w; }
    d -= 4;
    if (d < 4) { w.W = a.in[oidx(I_W1)] + (size_t)d * 1024 * 4096; w.WT = (bf16_t*)(ws + WS_W1) + (size_t)d * 4096 * 1024; w.K = 1024; w.Nsrc = 4096; w.Ndst = 4096; w.kind = 0; return w; }
    d -= 4;
    if (d < 4) { w.W = a.in[oidx(I_W2)] + (size_t)d * 4096 * 1024; w.WT = (bf16_t*)(ws + WS_W2) + (size_t)d * 1024 * 4096; w.K = 4096; w.Nsrc = 1024; w.Ndst = 1024; w.kind = 0; return w; }
    d -= 4;
    const int j = d & 1, k = d >> 1;
    switch (k) {
        case 0: w.W = a.in[oidx(I_AWIN)] + (size_t)j * 1024 * 1856; w.WT = (bf16_t*)(ws + WS_WIN) + (size_t)j * 2048 * 1024; w.K = 1024; w.Nsrc = 1856; w.Ndst = 2048; w.kind = 1; break;
        case 1: w.W = a.in[oidx(I_WUQ)] + (size_t)j * 512 * 768; w.WT = (bf16_t*)(ws + WS_UQ) + (size_t)j * 768 * 512; w.K = 512; w.Nsrc = 768; w.Ndst = 768; w.kind = 2; w.rscale = a.in[oidx(I_QNG)] + j * 512; break;
        case 2: w.W = a.in[oidx(I_WUKV)] + (size_t)j * 256 * 1024; w.WT = (bf16_t*)(ws + WS_UKV) + (size_t)j * 1024 * 256; w.K = 256; w.Nsrc = 1024; w.Ndst = 1024; w.kind = 3; w.rscale = a.in[oidx(I_KVNG)] + j * 256; break;
        case 3: w.W = a.in[oidx(I_AWOUT)] + (size_t)j * 1024 * 1024; w.WT = (bf16_t*)(ws + WS_AOUT) + (size_t)j * 1024 * 1024; w.K = 1024; w.Nsrc = 1024; w.Ndst = 1024; w.kind = 0; break;
        case 4: w.W = a.in[oidx(I_FCWIN)] + (size_t)j * 1024 * 1536; w.WT = (bf16_t*)(ws + WS_FCIN) + (size_t)j * 1536 * 1024; w.K = 1024; w.Nsrc = 1536; w.Ndst = 1536; w.kind = 4; break;
        default: w.W = a.in[oidx(I_FCWOUT)] + (size_t)j * 1024 * 1024; w.WT = (bf16_t*)(ws + WS_FCOUT) + (size_t)j * 1024 * 1024; w.K = 1024; w.Nsrc = 1024; w.Ndst = 1024; w.kind = 0; break;
    }
    return w;
}
__device__ __forceinline__ void setup_phase(const Args& a, unsigned char* wsl, float* outl, LAS unsigned char* lds, int wv) {
    const int tid = otid(wv), lane = tid & 63, wave = tid >> 6;
    const int gw = blockIdx.x * NWAVES + wave, NGW = gridDim.x * NWAVES;
    LAS float* scr = (LAS float*)(lds + wave * 16896);
    for (int d = 0; d < 24; ++d) {
        const WDesc w = wdesc(a, wsl, outl, d);
        const int nitems = (w.K / 64) * (w.Ndst / 64);
        for (int it = gw; it < nitems; it += NGW) transpose_item(w.W, w.K, w.Nsrc, w.Ndst, w.WT, w.kind, w.rscale, scr, it, lane);
    }
    const int gt = blockIdx.x * NTHREADS + tid, NGT = gridDim.x * NTHREADS;
    { bf16_t* A2 = (bf16_t*)(wsl + WS_A2); const float sc = 0.022097086912079608f;
      for (int i = gt; i < 2048 * 2048 / 8; i += NGT) { const int k = i >> 8, c0 = (i & 255) * 8; float v[8];
#pragma unroll
          for (int e = 0; e < 8; ++e) { const int c = c0 + e, t = c <= 1024 ? c : c - 1024; const int r = (k * t) & 2047; const float x = (float)(2 * r) * (1.f / 2048.f);
              v[e] = (c <= 1024 ? cospif(x) : -sinpif(x)) * sc; }
          *(u32x4*)(A2 + (size_t)i * 8) = pack8(v); } }
    { bf16_t* A2c = (bf16_t*)(wsl + WS_A2C);
      for (int i = gt; i < 256 * 256 / 8; i += NGT) { const int k = i >> 5, c0 = (i & 31) * 8; float v[8];
#pragma unroll
          for (int e = 0; e < 8; ++e) { const int c = c0 + e, t = c <= 128 ? c : c - 128; const int r = (k * t) & 255; const float x = (float)(2 * r) * (1.f / 256.f);
              v[e] = (c <= 128 ? cospif(x) : -sinpif(x)) * 0.0625f; }
          *(u32x4*)(A2c + (size_t)i * 8) = pack8(v); } }
    { bf16_t* Wcs = (bf16_t*)(wsl + WS_WCS); const float sc = 0.08838834764831845f;
      for (int i = gt; i < 256 * 128 / 8; i += NGT) { const int rw = i >> 4, c0 = (i & 15) * 8, l = rw & 127; float v[8];
#pragma unroll
          for (int e = 0; e < 8; ++e) { const int c = c0 + e; const int r = (l * c) & 127; const float x = (float)(2 * r) * (1.f / 128.f);
              v[e] = (rw < 128 ? cospif(x) : sinpif(x)) * sc; }
          *(u32x4*)(Wcs + (size_t)i * 8) = pack8(v); } }
    { bf16_t* SC = (bf16_t*)(wsl + WS_SC);
      for (int i = gt; i < 256 * 1024 / 8; i += NGT) { const int rw = i >> 7, c0 = (i & 127) * 8; float v[8];
#pragma unroll
          for (int e = 0; e < 8; ++e) { float x = 0.f; if (rw < 32) x = a.in[oidx(I_C)][rw * 1024 + c0 + e]; else if (rw == 32) x = a.in[oidx(I_CCTX)][c0 + e];
              v[e] = rw <= 32 ? x / (1.f + __expf(-x)) : 0.f; }
          *(u32x4*)(SC + (size_t)i * 8) = pack8(v); } }
}

__device__ __forceinline__ void norm_phase(const Args& a, unsigned char* wsl, float* outl, int layer, int which, int mrows, int wv) {
    const int tid = otid(wv), lane = tid & 63, wave = tid >> 6;
    const int gw = blockIdx.x * NWAVES + wave, NGW = gridDim.x * NWAVES;
    const bool first = (layer == 0 && which == 0);
    const float* g = a.in[which ? I_N2G : I_N1G] + layer * 1024;
    const float* MOD = (const float*)(wsl + WS_MOD) + (size_t)layer * NMODROW * 6144;
    bf16_t* X = (bf16_t*)(wsl + WS_X); bf16_t* H = (bf16_t*)(wsl + WS_H);
    const float* xin = a.in[oidx(I_X)]; const float* cin = a.in[oidx(I_CTX)];
    f32x4 nx[4];
    if (gw < mrows) { const float* src = gw < ML ? xin + (size_t)gw * DM : cin + (size_t)(gw - ML) * DM;
#pragma unroll
        for (int j = 0; j < 4; ++j) nx[j] = __builtin_nontemporal_load((const f32x4*)(src + lane * 4 + 256 * j)); }
    for (int m = gw; m < mrows; m += NGW) {
        const int brow = m < ML ? (m >> 11) : 32;
        const float* sh = MOD + (size_t)brow * 6144 + (which ? 3 : 0) * 1024; const float* scp = sh + 1024;
        f32x4 v[4]; float ss = 0.f;
#pragma unroll
        for (int j = 0; j < 4; ++j) { v[j] = nx[j]; ss += (v[j].x * v[j].x + v[j].y * v[j].y) + (v[j].z * v[j].z + v[j].w * v[j].w); }
        { const int mn = m + NGW; if (mn < mrows) { const float* src = mn < ML ? xin + (size_t)mn * DM : cin + (size_t)(mn - ML) * DM;
#pragma unroll
            for (int j = 0; j < 4; ++j) nx[j] = __builtin_nontemporal_load((const f32x4*)(src + lane * 4 + 256 * j)); } }
        if (first) {
#pragma unroll
            for (int j = 0; j < 4; ++j) __builtin_nontemporal_store((unsigned long long)cvt_pk(v[j].x, v[j].y) | ((unsigned long long)cvt_pk(v[j].z, v[j].w) << 32), (unsigned long long*)(X + (size_t)m * DM + lane * 4 + 256 * j));
        }
        const float rstd = rsqrtf(wave_sum(ss) * (1.f / DM) + EPS);
#pragma unroll
        for (int j = 0; j < 4; ++j) { const int c = lane * 4 + 256 * j;
            const f32x4 gg = *(const f32x4*)(g + c), s1 = *(const f32x4*)(scp + c), s0 = *(const f32x4*)(sh + c);
            const f32x4 h = (v[j] * rstd * gg) * (s1 + 1.f) + s0;
            unsigned long long o = (unsigned long long)cvt_pk(h.x, h.y) | ((unsigned long long)cvt_pk(h.z, h.w) << 32);
            *(unsigned long long*)(H + (size_t)m * DM + c) = o; }
    }
}
__device__ __forceinline__ void final_phase(const Args& a, unsigned char* wsl, float* outl, int wv) {
    const int tid = otid(wv), lane = tid & 63, wave = tid >> 6;
    const int gw = blockIdx.x * NWAVES + wave, NGW = gridDim.x * NWAVES;
    const float* g = a.in[oidx(I_FING)];
    const bf16_t* X = (const bf16_t*)(wsl + WS_X);
    unsigned long long nx[4] = {0ull, 0ull, 0ull, 0ull};
    if (gw < ML) {
#pragma unroll
        for (int j = 0; j < 4; ++j) nx[j] = __builtin_nontemporal_load((const unsigned long long*)(X + (size_t)gw * DM + lane * 4 + 256 * j)); }
    for (int m = gw; m < ML; m += NGW) {
        float* p = outl + (size_t)m * DM;
        f32x4 v[4]; float ss = 0.f;
#pragma unroll
        for (int j = 0; j < 4; ++j) { const unsigned long long w = nx[j];
            v[j] = (f32x4){bf_lo((unsigned)w), bf_hi((unsigned)w), bf_lo((unsigned)(w >> 32)), bf_hi((unsigned)(w >> 32))}; ss += (v[j].x * v[j].x + v[j].y * v[j].y) + (v[j].z * v[j].z + v[j].w * v[j].w); }
        if (m + NGW < ML) {
#pragma unroll
            for (int j = 0; j < 4; ++j) nx[j] = __builtin_nontemporal_load((const unsigned long long*)(X + (size_t)(m + NGW) * DM + lane * 4 + 256 * j)); }
        const float rstd = rsqrtf(wave_sum(ss) * (1.f / DM) + EPS);
#pragma unroll
        for (int j = 0; j < 4; ++j) { const int c = lane * 4 + 256 * j; const f32x4 gg = *(const f32x4*)(g + c); __builtin_nontemporal_store(v[j] * rstd * gg, (f32x4*)(p + c)); }
    }
}

__device__ __forceinline__ void q1_phase(const Args& a, unsigned char* wsl, float* outl, int j, int wv) {
    const int tid = otid(wv), lane = tid & 63, wave = tid >> 6;
    const int gw = blockIdx.x * NWAVES + wave, NGW = gridDim.x * NWAVES;
    const bf16_t* P = (const bf16_t*)(wsl + R_P);
    bf16_t* CQ = (bf16_t*)(wsl + R_CQ); bf16_t* QG = (bf16_t*)(wsl + R_QG); bf16_t* CKV = (bf16_t*)(wsl + R_CKV);
    bf16_t* KG = (bf16_t*)(wsl + R_KG); bf16_t* VG = (bf16_t*)(wsl + R_VG); bf16_t* KR = (bf16_t*)(wsl + R_KR);
    const float* gq = a.in[oidx(I_QNG)] + j * 512; const float* gkv = a.in[oidx(I_KVNG)] + j * 256;
    const float* ggq = a.in[oidx(I_GQNG)] + j * 128; const float* ggk = a.in[oidx(I_GKNG)] + j * 128;
    const int l16 = lane & 15;
    u32x4 nx0 = {0u, 0u, 0u, 0u}, nx1 = nx0, nx2 = nx0, nx3 = nx0;
    if (gw < MT) { const bf16_t* pr = P + (size_t)gw * 2048; nx0 = *(const u32x4*)(pr + lane * 8); nx1 = *(const u32x4*)(pr + 512 + lane * 8); nx2 = *(const u32x4*)(pr + 1024 + lane * 8); nx3 = *(const u32x4*)(pr + 1536 + lane * 8); }
    for (int m = gw; m < MT; m += NGW) {
        const bool lat = m < ML; const int t = m & 2047; const int prow = t >> 6, pcol = t & 63;
        const int kr = kvrow_of(m);
        float v[8];
        const u32x4 w0 = nx0, w1 = nx1, w2 = nx2, w3 = nx3;
        if (m + NGW < MT) { const bf16_t* pr = P + (size_t)(m + NGW) * 2048; nx0 = *(const u32x4*)(pr + lane * 8); nx1 = *(const u32x4*)(pr + 512 + lane * 8); nx2 = *(const u32x4*)(pr + 1024 + lane * 8); nx3 = *(const u32x4*)(pr + 1536 + lane * 8); }
        { unpack8(w0, v); float ss = 0.f;
#pragma unroll
          for (int e = 0; e < 8; ++e) ss += v[e] * v[e];
          const float rstd = rsqrtf(wave_sum(ss) * (1.f / 512.f) + EPS);
          const f32x4 g0 = *(const f32x4*)(gq + lane * 8), g1 = *(const f32x4*)(gq + lane * 8 + 4);
#pragma unroll
          for (int e = 0; e < 4; ++e) { v[e] = v[e] * rstd * g0[e]; v[4 + e] = v[4 + e] * rstd * g1[e]; }
          *(u32x4*)(CQ + (size_t)m * 512 + lane * 8) = pack8(v); }
        { unpack8(w1, v); float ss = 0.f;
#pragma unroll
          for (int e = 0; e < 8; ++e) ss += v[e] * v[e];
          ss += sx<1>(ss); ss += sx<2>(ss); ss += sx<4>(ss); ss += sx<8>(ss);
          const float rstd = rsqrtf(ss * (1.f / 128.f) + EPS);
          const f32x4 g0 = *(const f32x4*)(ggq + l16 * 8), g1 = *(const f32x4*)(ggq + l16 * 8 + 4);
#pragma unroll
          for (int e = 0; e < 4; ++e) { v[e] = v[e] * rstd * g0[e]; v[4 + e] = v[4 + e] * rstd * g1[e]; }
          rope8<4>(v, l16 >> 3, (l16 & 4) == 0, (l16 & 3) * 8, 1.f / 32.f, prow, pcol, lat);
          *(u32x4*)(QG + (size_t)m * 512 + lane * 8) = pack8(v); }
        { unpack8(w2, v); float ss = 0.f;
#pragma unroll
          for (int e = 0; e < 8; ++e) ss += v[e] * v[e];
          ss += sx<1>(ss); ss += sx<2>(ss); ss += sx<4>(ss); ss += sx<8>(ss);
          const float s32 = ss + sx<16>(ss);
          const bool lo = lane < 32;
          const float rstd = lo ? rsqrtf(s32 * (1.f / 256.f) + EPS) : rsqrtf(ss * (1.f / 128.f) + EPS);
          const float* gp = lo ? gkv + lane * 8 : ggk + l16 * 8;
          const f32x4 g0 = *(const f32x4*)gp, g1 = *(const f32x4*)(gp + 4);
#pragma unroll
          for (int e = 0; e < 4; ++e) { v[e] = v[e] * rstd * g0[e]; v[4 + e] = v[4 + e] * rstd * g1[e]; }
          rope8<4>(v, l16 >> 3, (l16 & 4) == 0, (l16 & 3) * 8, 1.f / 32.f, prow, pcol, lat && !lo);
          bf16_t* dst = lo ? CKV + (size_t)m * 256 + lane * 8 : KG + (size_t)kr * 256 + (lane - 32) * 8;
          *(u32x4*)dst = pack8(v); }
        { const u32x4 w = w3; unpack8(w, v);
          const int l8 = lane & 7;
          rope8<2>(v, l8 >> 2, (l8 & 2) == 0, (l8 & 1) * 8, 1.f / 16.f, prow, pcol, lat && lane >= 32 && lane < 40);
          if (lane < 32) *(u32x4*)(VG + (size_t)kr * 256 + lane * 8) = w;
          else if (lane < 40) *(u32x4*)(KR + (size_t)kr * 64 + (lane - 32) * 8) = pack8(v); }
    }
}

__device__ __forceinline__ void conv_phase(const Args& a, unsigned char* wsl, float* outl, int j, bool with_ctx, LAS unsigned char* lds, int wv) {
    const int tid = otid(wv), lane = tid & 63, wave = tid >> 6;
    const bf16_t* Ub = (const bf16_t*)(wsl + R_U); bf16_t* MIX = (bf16_t*)(wsl + WS_H);
    float w[31];
#pragma unroll
    for (int k = 0; k < 31; ++k) w[k] = a.in[oidx(I_CONVW)][((size_t)j * 31 + k) * 512 + tid];
    const float cb = a.in[oidx(I_CONVB)][j * 512 + tid];
    const float* lg = a.in[oidx(I_LNG)] + j * 512 + lane * 8; const float* lb = a.in[oidx(I_LNB)] + j * 512 + lane * 8;
    const f32x4 lg0 = *(const f32x4*)lg, lg1 = *(const f32x4*)(lg + 4), lb0 = *(const f32x4*)lb, lb1 = *(const f32x4*)(lb + 4);
    LAS bf16_t* U = (LAS bf16_t*)lds; LAS float* Y = (LAS float*)(lds + 65536);
    {
        const bf16_t* PF = (const bf16_t*)(wsl + R_P); const bf16_t* Wc = (const bf16_t*)(wsl + WS_WCS);
        const int nrow = 32 * 512 * (with_ctx ? 2 : 1);
        for (int idx = blockIdx.x * NTHREADS + tid; idx < nrow; idx += gridDim.x * NTHREADS) {
            const bool cx = idx >= 32 * 512; const int r = cx ? idx - 32 * 512 : idx, b = r >> 9, gl = r & 511, g = gl >> 7, l = gl & 127;
            const bf16_t* xr = PF + (size_t)(cx ? ML + b * 256 + 128 : b * 2048 + 1024) * 512 + g * 128; const bf16_t* wrow = Wc + l * 128;
            float acc = 0.f;
#pragma unroll
            for (int c8 = 0; c8 < 16; ++c8) { float xv[8], wv8[8]; unpack8(*(const u32x4*)(xr + c8 * 8), xv); unpack8(*(const u32x4*)(wrow + c8 * 8), wv8);
#pragma unroll
                for (int e = 0; e < 8; ++e) acc = fmaf(xv[e], wv8[e], acc); }
            bf16_t* dst = cx ? (bf16_t*)(wsl + R_YTFC) + (size_t)r * 256 + 128 : (bf16_t*)(wsl + R_YTF) + (size_t)r * 2048 + 1024;
            *dst = (bf16_t)(cvt_pk(acc, 0.f) & 0xffffu);
        }
    }
    const int nunits = 32 * 64 + (with_ctx ? 32 * 8 : 0);
    const int cvcu = (gridDim.x % 8 == 0) ? (blockIdx.x % 8) * (gridDim.x / 8) + blockIdx.x / 8 : blockIdx.x;
    for (int u = cvcu; u < nunits; u += gridDim.x) {
        int base, T, t0;
        if (u < 2048) { base = (u >> 6) * 2048; T = 2048; t0 = (u & 63) * 32; } else { const int uu = u - 2048; base = ML + (uu >> 3) * 256; T = 256; t0 = (uu & 7) * 32; }
        __syncthreads();
        {
            u32x4 ar[8];
#pragma unroll
            for (int q = 0; q < 8; ++q) { const int it = tid + q * NTHREADS, pi = it >> 6, c8 = (it & 63) * 8, p = t0 - 15 + pi;
                const bool ok = (it < 62 * 64) && p >= 0 && p < T;
                ar[q] = ok ? *(const u32x4*)(Ub + (size_t)(base + p) * 512 + c8) : (u32x4){0u, 0u, 0u, 0u}; }
#pragma unroll
            for (int q = 0; q < 8; ++q) { const int it = tid + q * NTHREADS, pi = it >> 6, c8 = (it & 63) * 8;
                if (it < 62 * 64) *(LAS u32x4*)(U + pi * 512 + c8) = ar[q]; }
        }
        __syncthreads();
#pragma unroll 1
        for (int tb = 0; tb < 4; ++tb) {
            float x[38];
#pragma unroll
            for (int i = 0; i < 38; ++i) x[i] = __uint_as_float((unsigned)U[(tb * 8 + i) * 512 + tid] << 16);
            float acc[8];
#pragma unroll
            for (int t = 0; t < 8; ++t) acc[t] = cb;
#pragma unroll
            for (int t = 0; t < 8; ++t)
#pragma unroll
                for (int k = 0; k < 31; ++k) acc[t] = fmaf(w[k], x[t + k], acc[t]);
#pragma unroll
            for (int t = 0; t < 8; ++t) Y[(tb * 8 + t) * 512 + tid] = acc[t];
        }
        __syncthreads();
        for (int t = wave; t < 32; t += NWAVES) {
            const f32x4 y0 = *(const LAS f32x4*)(Y + t * 512 + lane * 8), y1 = *(const LAS f32x4*)(Y + t * 512 + lane * 8 + 4);
            const float mean = wave_sum((y0.x + y0.y) + (y0.z + y0.w) + (y1.x + y1.y) + (y1.z + y1.w)) * (1.f / 512.f);
            const f32x4 d0 = y0 - mean, d1 = y1 - mean;
            const float var = wave_sum((d0.x * d0.x + d0.y * d0.y) + (d0.z * d0.z + d0.w * d0.w) + (d1.x * d1.x + d1.y * d1.y) + (d1.z * d1.z + d1.w * d1.w)) * (1.f / 512.f);
            const float rstd = rsqrtf(var + EPS);
            const f32x4 z0 = d0 * rstd * lg0 + lb0, z1 = d1 * rstd * lg1 + lb1;
            float o[8];
#pragma unroll
            for (int e = 0; e < 4; ++e) { o[e] = z0[e] / (1.f + __expf(-z0[e])); o[4 + e] = z1[e] / (1.f + __expf(-z1[e])); }
            *(u32x4*)(MIX + (size_t)(base + t0 + t) * 1024 + 512 + lane * 8) = pack8(o);
        }
    }
    __syncthreads();
}


__device__ __forceinline__ void fold_rows(const bf16_t* Yt, bf16_t* Yf, int N, int lgN, int gt, int NGT, int rev) {
    const int vpr = N >> 3, nvec = 32 * 512 * vpr, H = N >> 1;
    for (int ib = gt; ib < nvec; ib += 4 * NGT) {
        u32x4 wf[4], w0[4], w1[4]; unsigned wh[4];
#pragma unroll
        for (int q = 0; q < 4; ++q) { const int i0 = ib + q * NGT; const bool ok = i0 < nvec; const int i = ok ? (rev ? nvec - 1 - i0 : i0) : 0;
            const int rowi = i >> (lgN - 3), j0 = (i & (vpr - 1)) * 8;
            const bf16_t* yc = Yt + (size_t)rowi * 2 * N; const bool sinp = j0 >= H; const int t0 = sinp ? j0 - H : j0;
            const bf16_t* y = sinp ? yc + N : yc; const int a = N - t0 - 8;
            wf[q] = *(const u32x4*)(y + t0); w0[q] = *(const u32x4*)(y + a); w1[q] = *(const u32x4*)(y + (t0 > 0 ? a + 8 : a)); wh[q] = yc[H]; }
#pragma unroll
        for (int q = 0; q < 4; ++q) { const int i0 = ib + q * NGT; if (i0 < nvec) { const int i = rev ? nvec - 1 - i0 : i0;
            const int rowi = i >> (lgN - 3), j0 = (i & (vpr - 1)) * 8; const bool sinp = j0 >= H; const int t0 = sinp ? j0 - H : j0;
            float f[8], m0[8], m1[8], o[8]; unpack8(wf[q], f); unpack8(w0[q], m0); unpack8(w1[q], m1);
#pragma unroll
            for (int e = 0; e < 8; ++e) { const float p = (e == 0) ? (t0 > 0 ? m1[0] : 0.f) : m0[8 - e]; o[e] = sinp ? f[e] - p : f[e] + p; }
            if (t0 == 0) o[0] = sinp ? bf_lo(wh[q]) : f[0];
            *(u32x4*)(Yf + (size_t)rowi * N + j0) = pack8(o); } }
    }
}
__device__ __forceinline__ void fold_phase(unsigned char* wsl, bool with_ctx, int rev, int wv) {
    const int tid = otid(wv);
    const int gt = blockIdx.x * NTHREADS + tid, NGT = gridDim.x * NTHREADS;
    fold_rows((const bf16_t*)(wsl + R_YT), (bf16_t*)(wsl + R_YTF), 2048, 11, gt, NGT, rev);
    if (with_ctx) fold_rows((const bf16_t*)(wsl + R_YTC), (bf16_t*)(wsl + R_YTFC), 256, 8, gt, NGT, rev);
}

__device__ __forceinline__ void attn_phase(const Args& a, unsigned char* wsl, float* outl, bool with_ctx, char* lds, int wv) {
    const int G = gridDim.x, bx = blockIdx.x;
    const int vcu = (G % 8 == 0) ? (bx % 8) * (G / 8) + bx / 8 : bx;
    unsigned char* ws = wsl;
    const bf16_t* QM = (const bf16_t*)(ws + R_QM); const bf16_t* QR = (const bf16_t*)(ws + R_QR); const bf16_t* KM = (const bf16_t*)(ws + R_KM); const bf16_t* VM = (const bf16_t*)(ws + R_VM);
    const bf16_t* QG = (const bf16_t*)(ws + R_QG); const bf16_t* KG = (const bf16_t*)(ws + R_KG); const bf16_t* VG = (const bf16_t*)(ws + R_VG); const bf16_t* KR = (const bf16_t*)(ws + R_KR);
    bf16_t* O = (bf16_t*)(ws + WS_H);
    const int n_long = 2048, n_short = with_ctx ? 256 : 0;
    for (int idx = vcu; idx < n_long + n_short; idx += G) {
        int kind, b, h, qrow, seq;
        if (idx < n_long) { kind = idx >> 10; const int rem = idx & 1023; b = rem >> 5; h = (rem >> 3) & 3; qrow = b * SEQ + (rem & 7) * 256; seq = KVL; }
        else { const int i2 = idx - n_long; kind = i2 >> 7; b = (i2 >> 2) & 31; h = i2 & 3; qrow = ML + b * CTXL; seq = CTXL; }
        const size_t kv0 = (size_t)b * KVL;
        att::Job J;
        if (kind == 0) { J.Q = QM + (size_t)qrow * 512 + h * 128; J.ldq = 512; J.Q2 = QR + (size_t)qrow * 256 + h * 64; J.ldq2 = 256;
            J.K = KM + kv0 * 512 + h * 128; J.V = VM + kv0 * 512 + h * 128; J.ldk = 512; J.K2 = KR + kv0 * 64;
            J.O = O + (size_t)qrow * 1024 + h * 128; J.scale = 0.07216878364870322f; J.rope = 1; }
        else { J.Q = QG + (size_t)qrow * 512 + h * 128; J.ldq = 512; J.Q2 = J.Q; J.ldq2 = 512;
            J.K = KG + kv0 * 256 + (h >> 1) * 128; J.V = VG + kv0 * 256 + (h >> 1) * 128; J.ldk = 256; J.K2 = J.K;
            J.O = O + (size_t)qrow * 1024 + 512 + h * 128; J.scale = 0.08838834764831845f; J.rope = 0; }
        J.ldo = 1024; J.seq = seq;
        __syncthreads();
        if (kind == 0) att::attn_unit<true>(J, lds, wv); else att::attn_unit<false>(J, lds, wv);
    }
    __syncthreads();
}

enum { T_SETUP = 0, T_ADALN, T_PRE, T_G1, T_Q1, T_G2, T_AT, T_G3, T_G4, T_G5, T_CONV, T_D2, T_FINAL, T_FOLD };
struct Job { pg8::Gemm g; pg8::Sched s; pg8::Epi e; };
__device__ __forceinline__ void store_epi(pg8::Epi& e, int mode, bf16_t* C, int ldc) { e.mode = mode; e.C = C; e.C2 = C; e.ldc = ldc; e.rmask = 0x7fffffff; e.rshift = 31; e.rstep = 0; e.c_z = 0; }
__device__ __forceinline__ Job make_job(const Args& a, unsigned char* wsl, float* outl, LAS unsigned char* ldsl, int type, int layer, int jobi, int mtiles, int rev) {
    Job J; unsigned char* ws = wsl; const int j = layer >> 1; const bool attnl = (layer & 1) == 0;
    pg8::Sched& s = J.s; pg8::Epi& e = J.e;
    s.G = gridDim.x; s.c = blockIdx.x; s.zdiv = 1; s.a_z = 0; s.b_z1 = 0; s.b_z2 = 0;
    e.mode = 0; e.C = nullptr; e.C2 = nullptr; e.ldc = 0; e.rmask = 0x7fffffff; e.rshift = 31; e.rstep = 0; e.c_z = 0;
    e.X = (bf16_t*)(ws + WS_X); e.gate = nullptr; e.bias = nullptr; e.modout = nullptr; e.shiftout = nullptr;
    e.elds = ldsl; e.wsb = ws; e.gqn = nullptr; e.gkn = nullptr; e.ssqc = (float*)(ws + WS_SSQC); e.ssqk = (float*)(ws + WS_SSQK); e.ssq = nullptr; e.sw = nullptr; e.xg = nullptr; e.ng = nullptr; e.nsc = nullptr; e.ssq_out = (float*)(ws + WS_SSQ);
    const bf16_t* A = nullptr; const bf16_t* B = nullptr; int lda = 0, ldb = 0, K = 0, nMz = mtiles, nN = 0, Z = 1; size_t hstepB = 0, btile = 0;
    const float* MOD = (const float*)(ws + WS_MOD) + (size_t)layer * NMODROW * 6144;
    switch (type) {
        case T_ADALN: A = (const bf16_t*)(ws + WS_SC); lda = 1024; B = (const bf16_t*)(ws + R_MODWT); ldb = 1024; K = 1024; nMz = 1; nN = 96;
            e.mode = pg8::M_MOD; e.bias = a.in[oidx(I_MODB)]; e.modout = (float*)(ws + WS_MOD); e.shiftout = (bf16_t*)(ws + WS_SHIFT); break;
        case T_PRE: {
            const int l = jobi >> 1, w = jobi & 1, jj = l >> 1;
            A = (const bf16_t*)(ws + WS_SHIFT) + (size_t)jobi * 64 * 1024; lda = 1024; ldb = 1024; K = 1024; nMz = 1;
            if (w) { B = (const bf16_t*)(ws + WS_W1) + (size_t)l * 4096 * 1024; nN = 16; }
            else if ((l & 1) == 0) { B = (const bf16_t*)(ws + WS_WIN) + (size_t)jj * 2048 * 1024; nN = 8; }
            else { B = (const bf16_t*)(ws + WS_FCIN) + (size_t)jj * 1536 * 1024; nN = 6; }
            e.mode = pg8::M_SW; e.modout = (float*)(ws + WS_SW) + (size_t)jobi * NMODROW * 4096;
            s.c = (blockIdx.x + 32 * jobi) % gridDim.x; } break;
        case T_G1: A = (const bf16_t*)(ws + WS_H); lda = 1024; ldb = 1024; K = 1024;
            if (attnl) { B = (const bf16_t*)(ws + WS_WIN) + (size_t)j * 2048 * 1024; nN = 8; e.mode = pg8::M_QKV; e.gqn = a.in[oidx(I_GQNG)] + j * 128; e.gkn = a.in[oidx(I_GKNG)] + j * 128; }
            else { B = (const bf16_t*)(ws + WS_FCIN) + (size_t)j * 1536 * 1024; nN = 6; e.mode = pg8::M_FCIN; }
            if (layer > 0) { e.ssq = (const float*)(ws + WS_SSQ); e.sw = (const float*)(ws + WS_SW) + (size_t)(layer * 2) * NMODROW * 4096; }
            break;
        case T_G2:
            if (jobi == 0) { if (layer == 2) nMz = ML / 256;
                A = (const bf16_t*)(ws + R_CQ); lda = 512; B = (const bf16_t*)(ws + WS_UQ) + (size_t)j * 768 * 512; ldb = 512; K = 512; nN = 3;
                e.mode = pg8::M_UQ; e.C = (bf16_t*)(ws + R_QM); e.C2 = (bf16_t*)(ws + R_QR); }
            else { A = (const bf16_t*)(ws + R_CKV); lda = 256; B = (const bf16_t*)(ws + WS_UKV) + (size_t)j * 1024 * 256; ldb = 256; K = 256; nN = 4;
                e.mode = pg8::M_UKV; e.C = (bf16_t*)(ws + R_KM); e.C2 = (bf16_t*)(ws + R_VM); }
            break;
        case T_G3: A = (const bf16_t*)(ws + WS_H); lda = 1024; ldb = 1024; K = 1024; nN = 4;
            B = attnl ? (const bf16_t*)(ws + WS_AOUT) + (size_t)j * 1024 * 1024 : (const bf16_t*)(ws + WS_FCOUT) + (size_t)j * 1024 * 1024;
            e.mode = pg8::M_RESID; e.gate = MOD + 2 * 1024;
            e.xg = (bf16_t*)outl; e.ng = a.in[oidx(I_N2G)] + layer * 1024; e.nsc = MOD + 4 * 1024; break;
        case T_G4: A = (const bf16_t*)outl; lda = 1024; B = (const bf16_t*)(ws + WS_W1) + (size_t)layer * 4096 * 1024; ldb = 1024; K = 1024; nN = 16;
            store_epi(e, pg8::M_RELU2, (bf16_t*)(ws + R_HID), 4096);
            e.ssq = (const float*)(ws + WS_SSQ); e.sw = (const float*)(ws + WS_SW) + (size_t)(layer * 2 + 1) * NMODROW * 4096; break;
        case T_G5: A = (const bf16_t*)(ws + R_HID); lda = 4096; B = (const bf16_t*)(ws + WS_W2) + (size_t)layer * 1024 * 4096; ldb = 4096; K = 4096; nN = 4;
            e.mode = pg8::M_RESID; e.gate = MOD + 5 * 1024;
            if (layer < 3) { e.xg = (bf16_t*)(ws + WS_H); e.ng = a.in[oidx(I_N1G)] + (layer + 1) * 1024; e.nsc = MOD + (size_t)NMODROW * 6144 + 1 * 1024; } break;
        case T_CONV:
            A = (const bf16_t*)(ws + WS_WCS); lda = 128; K = 128; nMz = 1; ldb = 512; s.zdiv = 4; Z = 128; s.b_z2 = 128 * 2; hstepB = R_PFM - R_P; btile = (size_t)128 * 512 * 2;
            e.mode = pg8::M_D1F;
            if (jobi == 0) { B = (const bf16_t*)(ws + R_P); s.b_z1 = (size_t)2048 * 512 * 2; nN = 8; e.C = (bf16_t*)(ws + R_YTF); e.ldc = 2048; }
            else { B = (const bf16_t*)(ws + R_P) + (size_t)ML * 512; s.b_z1 = (size_t)256 * 512 * 2; nN = 1; e.C = (bf16_t*)(ws + R_YTFC); e.ldc = 256; }
            break;
        default:
            Z = 32; nN = 2;
            if (jobi == 0) { A = (const bf16_t*)(ws + WS_A2); lda = 2048; K = 2048; nMz = 8; B = (const bf16_t*)(ws + R_YTF); ldb = 2048; s.b_z1 = (size_t)512 * 2048 * 2;
                store_epi(e, pg8::M_STORE, (bf16_t*)(ws + WS_H), 1024); e.c_z = (size_t)2048 * 1024; }
            else { A = (const bf16_t*)(ws + WS_A2C); lda = 256; K = 256; nMz = 1; B = (const bf16_t*)(ws + R_YTFC); ldb = 256; s.b_z1 = (size_t)512 * 256 * 2;
                store_epi(e, pg8::M_STORE, (bf16_t*)(ws + WS_H) + (size_t)ML * 1024, 1024); e.c_z = (size_t)256 * 1024; }
            break;
    }
    J.g.lda = lda; J.g.ldb = ldb; J.g.K = K; J.g.hstepB = hstepB;
    s.A = (const char*)A; s.B = (const char*)B; s.nMz = nMz; s.nN = nN; s.nVP = Z * nMz; s.nwg = s.nVP * nN;
    s.a_tile = (size_t)256 * lda * 2; s.b_tile = btile ? btile : (size_t)256 * ldb * 2;
    s.nmine = s.c < s.nwg ? (s.nwg - 1 - s.c) / s.G + 1 : 0; s.rev = rev;
    return J;
}


#define XB_TMO      128
#define XB_XCNT(j)  (256  + 64 * (j))
#define XB_XSUB(j)  (1280 + 64 * (j))
#define XB_XGEN(j)  (2304 + 64 * (j))
#define XB_TOP      3328
#define XB_TOPGEN   3392
#define XCD_BAR_WORDS 3456
#define XB_SPIN_CAP (1u << 18)
__device__ __forceinline__ unsigned xb_ld(unsigned* p)              { return __hip_atomic_load(p, __ATOMIC_RELAXED, __HIP_MEMORY_SCOPE_AGENT); }
__device__ __forceinline__ unsigned xb_add(unsigned* p, unsigned v) { return __hip_atomic_fetch_add(p, v, __ATOMIC_RELAXED, __HIP_MEMORY_SCOPE_AGENT); }
__device__ __forceinline__ unsigned xb_xcc_id() { return (unsigned)__builtin_amdgcn_s_getreg((3 << 11) | 20) & 0xFu; }
#define XB_SPIN(cond, bar) do { unsigned _sp = 0; while (cond) { __builtin_amdgcn_s_sleep(1); \
    if ((++_sp & 255u) == 0u) { if (xb_ld(&(bar)[XB_TMO])) break; if (_sp > XB_SPIN_CAP) { atomicAdd(&(bar)[XB_TMO], 1u); break; } } } } while (0)
struct XcdBarrier { unsigned* bar; unsigned x; volatile LAS unsigned* st; };
__device__ __forceinline__ XcdBarrier xcd_barrier_post(unsigned* bar, volatile LAS unsigned* st) {
    XcdBarrier b; b.bar = bar; b.x = xb_xcc_id(); b.st = st;
    if (threadIdx.x == 0) (void)xb_add(&bar[XB_XCNT(b.x)], 1u);
    return b;
}
__device__ __forceinline__ void xcd_barrier_complete(unsigned* bar, unsigned x, unsigned& nloc, unsigned& nx) {
    const unsigned G = gridDim.x * gridDim.y * gridDim.z;
    unsigned sum, cnt, mine, sp = 0u;
    for (;;) {
        sum = 0u; cnt = 0u; mine = 0u;
#pragma unroll
        for (unsigned j = 0; j < 16; ++j) { const unsigned c = xb_ld(&bar[XB_XCNT(j)]); sum += c; cnt += (c > 0u) ? 1u : 0u; mine = (j == x) ? c : mine; }
        if (sum == G) break;
        __builtin_amdgcn_s_sleep(1);
        if ((++sp & 255u) == 0u) { if (xb_ld(&bar[XB_TMO])) break; if (sp > XB_SPIN_CAP) { atomicAdd(&bar[XB_TMO], 1u); break; } }
    }
    nloc = mine > 0u ? mine : 1u; nx = cnt > 0u ? cnt : 1u;
}
__device__ __forceinline__ void xcd_barrier(const XcdBarrier& b) {
    asm volatile("s_waitcnt vmcnt(0)" ::: "memory");
    __syncthreads();
    if (threadIdx.x == 0) {
        unsigned* bar = b.bar;
        __builtin_amdgcn_s_waitcnt(0);
        unsigned nloc = b.st[0], nx = b.st[1];
        if (nloc == 0u) { xcd_barrier_complete(bar, b.x, nloc, nx); b.st[0] = nloc; b.st[1] = nx; }
        const unsigned old = xb_add(&bar[XB_XSUB(b.x)], 1u);
        const unsigned gen = old / nloc;
        if (old + 1u == (gen + 1u) * nloc) {
            __builtin_amdgcn_fence(__ATOMIC_RELEASE, "agent");
            asm volatile("s_waitcnt vmcnt(0)" ::: "memory");
            const unsigned og = xb_add(&bar[XB_TOP], 1u);
            const unsigned tg = og / nx;
            if (og + 1u == (tg + 1u) * nx) xb_add(&bar[XB_TOPGEN], 1u);
            else XB_SPIN(xb_ld(&bar[XB_TOPGEN]) == tg, bar);
            __builtin_amdgcn_fence(__ATOMIC_ACQUIRE, "agent");
            xb_add(&bar[XB_XGEN(b.x)], 1u);
            asm volatile("s_waitcnt vmcnt(0)" ::: "memory");
        } else {
            XB_SPIN(xb_ld(&bar[XB_XGEN(b.x)]) == gen, bar);
            __builtin_amdgcn_fence(__ATOMIC_ACQUIRE, "agent");
            asm volatile("s_waitcnt vmcnt(0)" ::: "memory");
        }
    }
    __syncthreads();
}

#ifndef DUP_MASK
#define DUP_MASK 0ull
#endif
#ifndef SKIP_MASK
#define SKIP_MASK 0ull
#endif
__global__ void __launch_bounds__(NTHREADS, 2) fwd_megakernel(Args args) {
    extern __shared__ __attribute__((aligned(16))) unsigned char lds[];
    cg::grid_group grid = cg::this_grid();
    LAS unsigned char* ldsl = (LAS unsigned char*)lds;
    const int wv = __builtin_amdgcn_readfirstlane(threadIdx.x >> 6);
    volatile LAS unsigned* bst = (volatile LAS unsigned*)(ldsl + LDS_BYTES - 64);
    if (threadIdx.x < 2) bst[threadIdx.x] = 0u;
    __syncthreads();
    const XcdBarrier bar = xcd_barrier_post((unsigned*)(args.ws + WS_CTL), bst);
    if (args.ph_hi < 0) grid.sync();
    for (int ph = args.ph_lo; ph < args.ph_hi; ++ph) {
        unsigned char* wsl = args.ws; float* outl = args.out;
        asm volatile("" : "+s"(wsl)); asm volatile("" : "+s"(outl));
        int type, layer = 0;
        if (ph == 0) type = T_SETUP;
        else if (ph == 1) type = T_ADALN;
        else if (ph == 2) type = T_PRE;
        else if (ph >= 27) type = T_FINAL;
        else {
            int q = ph - 3, sub;
            layer = q / 6; sub = q - layer * 6;
            if ((layer & 1) == 0) { const int tt[6] = {T_G1, T_G2, T_AT, T_G3, T_G4, T_G5}; type = T_G1;
#pragma unroll
                for (int i = 0; i < 6; ++i) if (sub == i) type = tt[i]; }
            else { const int tt[6] = {T_G1, T_CONV, T_D2, T_G3, T_G4, T_G5}; type = T_G1;
#pragma unroll
                for (int i = 0; i < 6; ++i) if (sub == i) type = tt[i]; }
        }
        int mrows = MT;
        if (layer == 3) mrows = ML;
        if (layer == 2 && (type == T_G3 || type == T_G4 || type == T_G5)) mrows = ML;
        const bool ctx_full = layer < 2;
        const int nrep = ((DUP_MASK >> ph) & 1ull) ? 2 : 1;
        for (int rep = 0; rep < nrep; ++rep) {
        if (rep) grid.sync();
        int njobs = 0;
        if ((SKIP_MASK >> ph) & 1ull) type = -1;
        switch (type) {
            case T_SETUP: setup_phase(args, wsl, outl, ldsl, wv); break;
            case T_PRE: norm_phase(args, wsl, outl, 0, 0, MT, wv); njobs = 8; break;
            case T_AT: attn_phase(args, wsl, outl, layer == 0, (char*)lds, wv); break;
            case T_CONV: conv_phase(args, wsl, outl, layer >> 1, ctx_full, ldsl, wv); njobs = ctx_full ? 2 : 1; break;
            case T_FINAL: final_phase(args, wsl, outl, wv); break;
            case T_G2: njobs = 2; break;
            case T_D2: njobs = ctx_full ? 2 : 1; break;
            case -1: break;
            default: njobs = 1; break;
        }
        for (int jb = 0; jb < njobs; ++jb) {
            const Job J = make_job(args, wsl, outl, ldsl, type, layer, jb, mrows / 256, ph & 1);
            pg8::gemm_phase(ldsl, J.g, J.s, J.e, wv);
        }
        }
        if (ph + 1 < args.ph_hi) xcd_barrier(bar);
    }
#ifdef EXTRA_SYNCS
    for (int i = 0; i < EXTRA_SYNCS; ++i) grid.sync();
#endif
}

#ifndef N_PHASES_RUN
#define N_PHASES_RUN 28
#endif
constexpr int N_PHASES = N_PHASES_RUN;
#ifndef MK_PER_PHASE
#define MK_PER_PHASE 0
#endif
extern "C" void kernel_launch(void* const* d_in, const int* in_sizes, int n_in, void* d_out, int out_size, void* d_ws, size_t ws_size, hipStream_t stream) {
    static int grid = 0;
    if (grid == 0) {
        if (n_in != 25 || in_sizes[0] != ML * DM || out_size != ML * DM || ws_size < WS_END) {
            fprintf(stderr, "kernel_launch: unexpected shapes: n_in %d in0 %d out %d ws %zu (need %zu)\n", n_in, n_in > 0 ? in_sizes[0] : -1, out_size, ws_size, (size_t)WS_END); grid = -1; return; }
        int dev = 0, cus = 0, per_cu = 0;
        hipGetDevice(&dev); hipDeviceGetAttribute(&cus, hipDeviceAttributeMultiprocessorCount, dev);
        if (hipFuncSetAttribute((const void*)fwd_megakernel, hipFuncAttributeMaxDynamicSharedMemorySize, LDS_BYTES) != hipSuccess) { fprintf(stderr, "kernel_launch: hipFuncSetAttribute failed\n"); grid = -1; return; }
        if (hipOccupancyMaxActiveBlocksPerMultiprocessor(&per_cu, (const void*)fwd_megakernel, NTHREADS, LDS_BYTES) != hipSuccess || per_cu < 1) { fprintf(stderr, "kernel_launch: occupancy query gave %d\n", per_cu); per_cu = 1; }
        (void)hipGetLastError();
        grid = cus * per_cu;
    }
    if (grid < 0) return;
    Args a{};
    for (int i = 0; i < 25; ++i) a.in[i] = (const float*)d_in[i];
    a.out = (float*)d_out; a.ws = (unsigned char*)d_ws;
#if MK_PER_PHASE
    for (int ph = 0; ph < N_PHASES; ++ph) {
        a.ph_lo = ph; a.ph_hi = ph + 1;
        hipLaunchKernelGGL(fwd_megakernel, dim3(grid), dim3(NTHREADS), LDS_BYTES, stream, a);
    }
#else
    a.ph_lo = 0; a.ph_hi = N_PHASES;
    if (hipMemsetAsync((char*)d_ws + WS_CTL, 0, 16384, stream) != hipSuccess) { fprintf(stderr, "kernel_launch: memset of the barrier words failed\n"); return; }
    void* kargs[] = {&a};
    hipError_t e = hipLaunchCooperativeKernel((const void*)fwd_megakernel, dim3(grid), dim3(NTHREADS), kargs, LDS_BYTES, stream);
    if (e != hipSuccess) fprintf(stderr, "kernel_launch: cooperative launch failed: %s (grid %d)\n", hipGetErrorString(e), grid);
#endif
}
```
